# Optimizing an MI355X kernel written in HIP

```python
import jax, jax.numpy as jnp
from jax import lax
import numpy as np

D_MODEL = 1024
BATCH = 8
SEQ = 4096
DEPTH = 2

CTX_LEN = 256
GRID_W = 64
W_LRU = 1024
LRU_HEADS = 16
LRU_HEAD_DIM = W_LRU // LRU_HEADS
CONV_W = 4
LRU_C = 8.0
W_FFT = 512
FFT_GROUPS = 4
FFT_GROUP_DIM = W_FFT // FFT_GROUPS
W_POOL = 512
POOL_WINDOWS = (2, 4, 8, 16)
POOL_GROUPS = len(POOL_WINDOWS)
POOL_GROUP_DIM = W_POOL // POOL_GROUPS
N_BRANCH = 3
IN_COLS = 2 * W_LRU + 2 * W_FFT + 2 * W_POOL + N_BRANCH * D_MODEL
SPLIT_POINTS = tuple(int(v) for v in np.cumsum([W_LRU, W_LRU, W_FFT, W_FFT, W_POOL, W_POOL]))
RMS_EPS = 1e-6
POS_BASE = 10000.0

kernel_name = "hybrid_rglru_fourier_pool_dit"


def rms_norm(x, g):
    xf = x.astype(jnp.float32)
    y = xf * lax.rsqrt(jnp.mean(xf * xf, axis=-1, keepdims=True) + RMS_EPS)
    return (y * g.astype(jnp.float32)).astype(x.dtype)


def sincos_2d(n_tokens, d, dtype):
    rows = n_tokens // GRID_W
    gr, gc = jnp.meshgrid(jnp.arange(rows), jnp.arange(GRID_W), indexing="ij")
    quarter = d // 4
    omega = 1.0 / (POS_BASE ** (jnp.arange(quarter, dtype=jnp.float32) / quarter))

    def emb(p):
        ang = p.reshape(-1).astype(jnp.float32)[:, None] * omega[None, :]
        return jnp.concatenate([jnp.sin(ang), jnp.cos(ang)], axis=-1)

    return jnp.concatenate([emb(gr), emb(gc)], axis=-1).astype(dtype)


def in_split(h, w_in):
    z = h @ w_in
    u_lru, z_lru, u_fft, z_fft, u_pool, z_pool, gate_logits = jnp.split(z, SPLIT_POINTS, axis=-1)
    return u_lru, z_lru, u_fft, z_fft, u_pool, z_pool, gate_logits


def depthwise_conv(u, w, b):
    pad = CONV_W // 2
    out = lax.conv_general_dilated(
        u, w[:, None, :], window_strides=(1,), padding=[(pad, CONV_W - 1 - pad)],
        dimension_numbers=("NWC", "WIO", "NWC"), feature_group_count=u.shape[-1])
    return out + b


def block_diag(u, w, b):
    bsz, t, _ = u.shape
    uh = u.reshape(bsz, t, LRU_HEADS, LRU_HEAD_DIM)
    return jnp.einsum("bthi,hij->bthj", uh, w).reshape(bsz, t, W_LRU) + b


def lru_coeffs(xc, wa, ba, wx, bx, lam):
    r = jax.nn.sigmoid(block_diag(xc, wa, ba)).astype(jnp.float32)
    i = jax.nn.sigmoid(block_diag(xc, wx, bx)).astype(jnp.float32)
    log_a = -LRU_C * r * jax.nn.softplus(-lam.astype(jnp.float32))
    a = jnp.exp(log_a)
    b = jnp.sqrt(-jnp.expm1(2.0 * log_a)) * (i * xc.astype(jnp.float32))
    return a, b


def linear_scan(a, b, h0):
    def combine(lft, rgt):
        return lft[0] * rgt[0], rgt[0] * lft[1] + rgt[1]
    acc_a, acc_h = lax.associative_scan(combine, (a, b), axis=1)
    return acc_h + acc_a * h0[:, None, :]


def lru_direction(xc_ctx, xc_lat, wa, ba, wx, bx, lam, reverse):
    flip = (lambda t: jnp.flip(t, axis=1)) if reverse else (lambda t: t)
    a_c, b_c = lru_coeffs(flip(xc_ctx), wa, ba, wx, bx, lam)
    h_c = linear_scan(a_c, b_c, jnp.zeros((xc_ctx.shape[0], W_LRU), jnp.float32))
    a_l, b_l = lru_coeffs(flip(xc_lat), wa, ba, wx, bx, lam)
    h_l = linear_scan(a_l, b_l, h_c[:, -1])
    return flip(h_c), flip(h_l)


def fourier_mix(u, w):
    bsz, t, _ = u.shape
    ug = u.reshape(bsz, t, FFT_GROUPS, FFT_GROUP_DIM).astype(jnp.float32)
    f = jnp.fft.fft2(ug, axes=(1, 3), norm="ortho").real.astype(u.dtype)
    return jnp.einsum("btgi,gij->btgj", f, w).reshape(bsz, t, W_FFT)


def pool_mix(u, w, scale):
    bsz, t, _ = u.shape
    uf = u.astype(jnp.float32)
    cs = jnp.concatenate([jnp.zeros_like(uf[:, :1]), jnp.cumsum(uf, axis=1)], axis=1)
    pos = jnp.arange(t)
    parts = []
    for g, win in enumerate(POOL_WINDOWS):
        sl = slice(g * POOL_GROUP_DIM, (g + 1) * POOL_GROUP_DIM)
        lo = jnp.clip(pos - win // 2, 0, t)
        hi = jnp.clip(pos + win - win // 2, 0, t)
        csg = cs[..., sl]
        cnt = (hi - lo).astype(jnp.float32)[None, :, None]
        mean = (jnp.take(csg, hi, axis=1) - jnp.take(csg, lo, axis=1)) / cnt
        parts.append(mean - uf[..., sl])
    p = jnp.concatenate(parts, axis=-1).astype(u.dtype).reshape(bsz, t, POOL_GROUPS, POOL_GROUP_DIM)
    y = jnp.einsum("btgi,gij->btgj", p, w).reshape(bsz, t, W_POOL)
    return y * scale


def branch_merge(y_lru, z_lru, y_fft, z_fft, y_pool, z_pool, gate_logits, proj_a, proj_b, proj_c, w_out):
    ya = (y_lru * jax.nn.silu(z_lru)) @ proj_a
    yb = (y_fft * jax.nn.silu(z_fft)) @ proj_b
    yc = (y_pool * jax.nn.silu(z_pool)) @ proj_c
    g = jax.nn.sigmoid(gate_logits.reshape(gate_logits.shape[:-1] + (N_BRANCH, D_MODEL)))
    m = g[..., 0, :] * ya + g[..., 1, :] * yb + g[..., 2, :] * yc
    return m @ w_out


def setup_inputs(seed: int = 0) -> dict:
    key = jax.random.key(seed)
    ks = jax.random.split(key, 24)
    f32 = jnp.float32
    nrm = lambda k, shape, s: jax.random.normal(k, shape, f32) * s
    u = jax.random.uniform(ks[14], (DEPTH, 2, W_LRU), f32, minval=0.9, maxval=0.999)
    s = u ** (1.0 / LRU_C)
    lam = jnp.log(s) - jnp.log1p(-s)
    return {
        "x": nrm(ks[0], (BATCH, SEQ, D_MODEL), 1.0),
        "c": nrm(ks[1], (BATCH, D_MODEL), 1.0),
        "ctx": nrm(ks[2], (BATCH, CTX_LEN, D_MODEL), 1.0),
        "c_ctx": nrm(ks[3], (D_MODEL,), 1.0),
        "norm_g": 1.0 + nrm(ks[4], (DEPTH, D_MODEL), 0.02),
        "ada_w": nrm(ks[5], (DEPTH, D_MODEL, 3 * D_MODEL), 0.5 * D_MODEL ** -0.5),
        "ada_b": nrm(ks[6], (DEPTH, 3 * D_MODEL), 0.01),
        "w_in": nrm(ks[7], (DEPTH, D_MODEL, IN_COLS), D_MODEL ** -0.5),
        "conv_w": nrm(ks[8], (DEPTH, CONV_W, W_LRU), CONV_W ** -0.5),
        "conv_b": nrm(ks[9], (DEPTH, W_LRU), 0.01),
        "lru_wa": nrm(ks[10], (DEPTH, 2, LRU_HEADS, LRU_HEAD_DIM, LRU_HEAD_DIM), LRU_HEAD_DIM ** -0.5),
        "lru_ba": nrm(ks[11], (DEPTH, 2, W_LRU), 0.01),
        "lru_wx": nrm(ks[12], (DEPTH, 2, LRU_HEADS, LRU_HEAD_DIM, LRU_HEAD_DIM), LRU_HEAD_DIM ** -0.5),
        "lru_bx": nrm(ks[13], (DEPTH, 2, W_LRU), 0.01),
        "lru_lam": lam,
        "fft_w": nrm(ks[15], (DEPTH, FFT_GROUPS, FFT_GROUP_DIM, FFT_GROUP_DIM), FFT_GROUP_DIM ** -0.5),
        "pool_w": nrm(ks[16], (DEPTH, POOL_GROUPS, POOL_GROUP_DIM, POOL_GROUP_DIM), POOL_GROUP_DIM ** -0.5),
        "pool_scale": 1.0 + nrm(ks[17], (DEPTH, W_POOL), 0.02),
        "proj_a": nrm(ks[18], (DEPTH, W_LRU, D_MODEL), W_LRU ** -0.5),
        "proj_b": nrm(ks[19], (DEPTH, W_FFT, D_MODEL), W_FFT ** -0.5),
        "proj_c": nrm(ks[20], (DEPTH, W_POOL, D_MODEL), W_POOL ** -0.5),
        "w_out": nrm(ks[21], (DEPTH, D_MODEL, D_MODEL), D_MODEL ** -0.5),
        "final_g": 1.0 + nrm(ks[22], (D_MODEL,), 0.02),
    }


def reference(x, c, ctx, c_ctx, norm_g, ada_w, ada_b, w_in, conv_w, conv_b, lru_wa, lru_ba, lru_wx, lru_bx,
              lru_lam, fft_w, pool_w, pool_scale, proj_a, proj_b, proj_c, w_out, final_g):
    n_lat = x.shape[1]
    x = x + sincos_2d(n_lat, x.shape[-1], x.dtype)[None]
    for l in range(DEPTH):
        last = l == DEPTH - 1
        mod_lat = jax.nn.silu(c) @ ada_w[l] + ada_b[l]
        mod_ctx = jax.nn.silu(c_ctx) @ ada_w[l] + ada_b[l]
        sh_l, sc_l, gt_l = jnp.split(mod_lat, 3, axis=-1)
        sh_c, sc_c, gt_c = jnp.split(mod_ctx, 3, axis=-1)
        h_lat = rms_norm(x, norm_g[l]) * (1.0 + sc_l[:, None]) + sh_l[:, None]
        h_ctx = rms_norm(ctx, norm_g[l]) * (1.0 + sc_c) + sh_c
        ul_lru, zl_lru, ul_fft, zl_fft, ul_pool, zl_pool, gl = in_split(h_lat, w_in[l])
        uc_lru, zc_lru, uc_fft, zc_fft, uc_pool, zc_pool, gc = in_split(h_ctx, w_in[l])
        xc_lat = depthwise_conv(ul_lru, conv_w[l], conv_b[l])
        xc_ctx = depthwise_conv(uc_lru, conv_w[l], conv_b[l])
        hc_f, hl_f = lru_direction(xc_ctx, xc_lat, lru_wa[l, 0], lru_ba[l, 0], lru_wx[l, 0], lru_bx[l, 0],
                                   lru_lam[l, 0], False)
        hc_b, hl_b = lru_direction(xc_ctx, xc_lat, lru_wa[l, 1], lru_ba[l, 1], lru_wx[l, 1], lru_bx[l, 1],
                                   lru_lam[l, 1], True)
        y_lru_lat = (hl_f + hl_b).astype(x.dtype)
        out_lat = branch_merge(y_lru_lat, zl_lru, fourier_mix(ul_fft, fft_w[l]), zl_fft,
                               pool_mix(ul_pool, pool_w[l], pool_scale[l]), zl_pool, gl,
                               proj_a[l], proj_b[l], proj_c[l], w_out[l])
        if not last:
            y_lru_ctx = (hc_f + hc_b).astype(ctx.dtype)
            out_ctx = branch_merge(y_lru_ctx, zc_lru, fourier_mix(uc_fft, fft_w[l]), zc_fft,
                                   pool_mix(uc_pool, pool_w[l], pool_scale[l]), zc_pool, gc,
                                   proj_a[l], proj_b[l], proj_c[l], w_out[l])
            ctx = ctx + gt_c * out_ctx
        x = x + gt_l[:, None] * out_lat
    return rms_norm(x, final_g)
```

```cpp
#include <hip/hip_runtime.h>
#include <hip/hip_cooperative_groups.h>
#include <cstdio>
namespace cg = cooperative_groups;

#define LAS __attribute__((address_space(3)))
typedef unsigned short bf16_t;
typedef short bf16x8 __attribute__((ext_vector_type(8)));
typedef float f32x4 __attribute__((ext_vector_type(4)));
typedef unsigned u32x4 __attribute__((ext_vector_type(4)));
typedef unsigned u32x2 __attribute__((ext_vector_type(2)));

constexpr int NB = 8, TL = 4096, TCX = 256, DM = 1024;
constexpr int NLAT = NB * TL, NCTX = NB * TCX, NT = NLAT + NCTX;
constexpr int INC = 7168;
constexpr int NCH = 68;
constexpr int LDS_ST = 139264;
constexpr int LDS_BYTES = LDS_ST + 256;
constexpr int XCD_BAR_WORDS_C = 3456;

constexpr size_t al256(size_t x) { return (x + 255) & ~(size_t)255; }
constexpr size_t WS_WINT = 0;
constexpr size_t WS_PAT = WS_WINT + al256((size_t)2 * INC * 1024 * 2);
constexpr size_t WS_PBCT = WS_PAT + al256((size_t)2 * 1024 * 1024 * 2);
constexpr size_t WS_WOT = WS_PBCT + al256((size_t)2 * 1024 * 1024 * 2);
constexpr size_t WS_GATE = WS_WOT + al256((size_t)2 * 1024 * 1024 * 2);
constexpr size_t WS_POOLT = WS_GATE + al256((size_t)2 * 16 * 256 * 64 * 2);
constexpr size_t WS_CWSW = WS_POOLT + al256((size_t)2 * 4 * 128 * 128 * 2);
constexpr size_t WS_F1 = WS_CWSW + al256((size_t)2 * 4 * 128 * 256 * 2);
constexpr size_t WS_G2 = WS_F1 + al256((size_t)128 * 64 * 2);
constexpr size_t WS_TW = WS_G2 + al256((size_t)128 * 128 * 2);
constexpr size_t WS_POS = WS_TW + al256((size_t)4096 * 2 * 4);
constexpr size_t WS_MOD = WS_POS + al256((size_t)64 * 512 * 4);
constexpr size_t WS_SP = WS_MOD + al256((size_t)2 * 9 * 3072 * 4);
constexpr size_t WS_H = WS_SP + al256((size_t)2 * 2 * 1024 * 4);
constexpr size_t WS_ULRU = WS_H + al256((size_t)NT * 1024 * 2);
constexpr size_t WS_AA = WS_ULRU + al256((size_t)NT * 1024 * 2);
constexpr size_t WS_ABC = WS_AA + al256((size_t)NT * 1024 * 2);
constexpr size_t WS_UFFT = WS_ABC + al256((size_t)NT * 1024 * 2);
constexpr size_t WS_UPOOL = WS_UFFT + al256((size_t)NT * 512 * 2);
constexpr size_t WS_APR = WS_UPOOL + al256((size_t)NT * 512 * 2);
constexpr size_t WS_CTXRES = WS_APR + al256((size_t)NB * 64 * 2 * 64 * 512 * 2);
constexpr size_t WS_AGGA = WS_CTXRES + al256((size_t)NCTX * 1024 * 4);
constexpr size_t WS_AGGH = WS_AGGA + al256((size_t)NB * 2 * NCH * 1024 * 4);
constexpr size_t WS_CIN = WS_AGGH + al256((size_t)NB * 2 * NCH * 1024 * 4);
constexpr size_t WS_BAR = WS_CIN + al256((size_t)NB * 2 * NCH * 1024 * 4);
constexpr size_t WS_END = WS_BAR + al256((size_t)XCD_BAR_WORDS_C * 4);

struct Params {
    const float* x; const float* c; const float* ctx; const float* c_ctx; const float* norm_g; const float* ada_w; const float* ada_b; const float* w_in;
    const float* conv_w; const float* conv_b; const float* lru_wa; const float* lru_ba; const float* lru_wx; const float* lru_bx; const float* lru_lam;
    const float* fft_w; const float* pool_w; const float* pool_scale; const float* proj_a; const float* proj_b; const float* proj_c; const float* w_out; const float* final_g;
    float* out; unsigned char* ws;
};

__device__ __forceinline__ const Params& kparams() { const __attribute__((address_space(4))) void* k = (const __attribute__((address_space(4))) void*)__builtin_amdgcn_kernarg_segment_ptr(); asm volatile("" : "+s"(k)); return *(const Params*)k; }
typedef float f32x2_t __attribute__((ext_vector_type(2)));
typedef __bf16 bf16x2_t __attribute__((ext_vector_type(2)));
__device__ __forceinline__ unsigned pk2(float lo, float hi) { f32x2_t v = {lo, hi}; bf16x2_t b = __builtin_convertvector(v, bf16x2_t); return __builtin_bit_cast(unsigned, b); }
__device__ __forceinline__ bf16_t f2bf(float f) { return (bf16_t)(pk2(f, 0.f) & 0xFFFFu); }
__device__ __forceinline__ float bf2f(bf16_t b) { return __uint_as_float(((unsigned)b) << 16); }
__device__ __forceinline__ float bflo(unsigned u) { return __uint_as_float(u << 16); }
__device__ __forceinline__ float bfhi(unsigned u) { return __uint_as_float(u & 0xFFFF0000u); }
__device__ __forceinline__ float sigm(float x) { return __fdividef(1.f, 1.f + __expf(-x)); }
__device__ __forceinline__ float silu(float x) { return __fdividef(x, 1.f + __expf(-x)); }
__device__ __forceinline__ float wave_sum(float v) {
#pragma unroll
    for (int o = 32; o > 0; o >>= 1) v += __shfl_xor(v, o, 64);
    return v;
}

__device__ __forceinline__ void lds_barrier() { asm volatile("s_waitcnt lgkmcnt(0)\n\ts_barrier" ::: "memory"); }
__device__ __forceinline__ int tid_op() { int t = threadIdx.x; asm volatile("" : "+v"(t)); return t; }
__device__ __forceinline__ int bid_op() { int t = __builtin_amdgcn_readfirstlane((int)blockIdx.x); asm volatile("" : "+s"(t)); return t; }
__device__ __forceinline__ int grd_op() { int t = __builtin_amdgcn_readfirstlane((int)gridDim.x); asm volatile("" : "+s"(t)); return t; }
__device__ __forceinline__ unsigned char* ptr_op(unsigned char* q) { unsigned lo = __builtin_amdgcn_readfirstlane((unsigned)(size_t)q), hi = __builtin_amdgcn_readfirstlane((unsigned)((size_t)q >> 32)); asm volatile("" : "+s"(lo), "+s"(hi)); return (unsigned char*)(((size_t)hi << 32) | lo); }

constexpr int BM = 256, BK = 64, HALF = 128, HTB = HALF * BK * 2, NXCD = 8, WGM = 8, LDK = 1024;
__device__ __forceinline__ int lds_byte(int r, int c) { const int st = (r >> 4) * 2 + (c >> 5), rr = r & 15, cc = c & 31, ob = rr * 64 + cc * 2; return st * 1024 + (ob ^ (((ob >> 9) & 1) << 5)); }
__device__ __forceinline__ void stage_rc(int b, int& R, int& C) { const int st = b / 1024, sb = b % 1024, swz = sb ^ (((sb >> 9) & 1) << 5); R = (st >> 1) * 16 + swz / 64; C = (st & 1) * 32 + (swz % 64) / 2; }
__device__ __forceinline__ int perm32(int rho) { const int n = rho >> 4, i = rho & 15; return 8 * (i >> 2) + 4 * n + (i & 3); }

struct GUnit { const char* A; const char* B; int nt; int kind; int pm; int pn; };

__device__ __forceinline__ void tile_of(int L, int nM, int nN, int& pm, int& pn) {
    const int nwg = nM * nN; int wgid = L;
    { const int q = nwg / NXCD, r = nwg % NXCD, xcd = wgid % NXCD, off = wgid / NXCD; wgid = (xcd < r ? xcd * (q + 1) : r * (q + 1) + (xcd - r) * q) + off; }
    const int nig = WGM * nN, gid = wgid / nig, fm = gid * WGM, gsz = (nM - fm) < WGM ? (nM - fm) : WGM;
    pm = fm + ((wgid % nig) % gsz); pn = (wgid % nig) / gsz;
}

template <class Sched, class Epi>
__device__ __forceinline__ void gemm_stream(LAS unsigned char* lds, const Sched& S, const Epi& E) {
    const int tid = tid_op(), wid = __builtin_amdgcn_readfirstlane(tid >> 6), lane = tid & 63, wr = wid >> 2, wc = wid & 3, fr = lane & 15, fq = lane >> 4;
    unsigned voffA[2], voffB[2];
#pragma unroll
    for (int i = 0; i < 2; ++i) { int R, C; stage_rc(tid * 16 + i * 8192, R, C); const int Rb = (R & ~31) + perm32(R & 31);
        voffA[i] = (unsigned)(R * LDK + C) * 2u; voffB[i] = (unsigned)(Rb * LDK + C) * 2u; }
    const size_t kstep = (size_t)(BK * 2);
    const size_t hstep = (size_t)HALF * LDK * 2;
    const unsigned ldsw = (unsigned)wid * 1024u;
    const int aoff = lds_byte(wr * 64 + fr, fq * 8), boff = lds_byte(wc * 32 + fr, fq * 8);
#define G_SA(b, h) (((b) * 2 + (h)) * HTB)
#define G_SB(b, h) ((4 + (b) * 2 + (h)) * HTB)
#define G_STAGE(bufoff, gbase, voff) do { _Pragma("unroll") for (int _i = 0; _i < 2; ++_i) \
        __builtin_amdgcn_global_load_lds((const unsigned*)((const char*)(gbase) + (voff)[_i]), (LAS unsigned*)(lds + (bufoff) + ldsw + _i * 8192), 16, 0, 0); } while (0)
#define G_LDA(dst, b, h) do { _Pragma("unroll") for (int m = 0; m < 4; ++m) _Pragma("unroll") for (int k = 0; k < 2; ++k) dst[m][k] = *(const LAS bf16x8*)(lds + G_SA(b, h) + aoff + m * 2048 + k * 1024); } while (0)
#define G_LDB(dst, b, h) do { _Pragma("unroll") for (int n = 0; n < 2; ++n) _Pragma("unroll") for (int k = 0; k < 2; ++k) dst[n][k] = *(const LAS bf16x8*)(lds + G_SB(b, h) + boff + n * 2048 + k * 1024); } while (0)
#define G_MMA(ai, bj, At, Bt) do { __builtin_amdgcn_s_setprio(1); _Pragma("unroll") for (int m = 0; m < 4; ++m) _Pragma("unroll") for (int n = 0; n < 2; ++n) _Pragma("unroll") for (int k = 0; k < 2; ++k) \
        acc[ai][bj][m][n] = __builtin_amdgcn_mfma_f32_16x16x32_bf16(Bt[n][k], At[m][k], acc[ai][bj][m][n], 0, 0, 0); __builtin_amdgcn_s_setprio(0); } while (0)
#define G_WAIT_V(n) asm volatile("s_waitcnt vmcnt(" #n ")" ::: "memory")
#define G_WAIT_L(n) asm volatile("s_waitcnt lgkmcnt(" #n ")" ::: "memory")
#define G_BAR __builtin_amdgcn_s_barrier()
#define G_SCHED __builtin_amdgcn_sched_barrier(0)
    GUnit cur, nxt; int ui = 0;
    if (!S.next(0, cur)) return;
    f32x4 acc[2][2][4][2];
#pragma unroll
    for (int a = 0; a < 2; ++a)
#pragma unroll
        for (int b = 0; b < 2; ++b)
#pragma unroll
            for (int m = 0; m < 4; ++m)
#pragma unroll
                for (int n = 0; n < 2; ++n) acc[a][b][m][n] = (f32x4){0.f, 0.f, 0.f, 0.f};
    bf16x8 At[4][2], B0[2][2], B1[2][2];
    const char* cA = cur.A; const char* cB = cur.B;
    G_STAGE(G_SB(0, 0), cB, voffB); G_STAGE(G_SA(0, 0), cA, voffA); G_STAGE(G_SB(0, 1), cB + hstep, voffB); G_STAGE(G_SA(0, 1), cA + hstep, voffA);
    if (wr == 1) G_BAR;
    G_WAIT_V(4); G_BAR;
    G_STAGE(G_SB(1, 0), cB + kstep, voffB); G_STAGE(G_SA(1, 0), cA + kstep, voffA); G_STAGE(G_SB(1, 1), cB + hstep + kstep, voffB);
    G_WAIT_V(6); G_BAR;
    for (;;) {
        const bool has_next = S.next(ui + 1, nxt);
        const char* nA = has_next ? nxt.A : cA; const char* nB = has_next ? nxt.B : cB;
        const int nt = cur.nt;
        for (int t = 0; t < nt; t += 2) {
            const bool last = (t == nt - 2);
            const char* a1 = cA + (size_t)(t + 1) * kstep;
            const char* a2 = last ? nA : cA + (size_t)(t + 2) * kstep; const char* b2 = last ? nB : cB + (size_t)(t + 2) * kstep;
            const char* a3 = a2 + kstep; const char* b3 = b2 + kstep;
            G_LDB(B0, 0, 0); G_SCHED; G_LDA(At, 0, 0); G_STAGE(G_SA(1, 1), a1 + hstep, voffA);
            G_WAIT_L(8); G_BAR; G_WAIT_L(0); G_MMA(0, 0, At, B0); G_BAR; G_SCHED;
            G_LDB(B1, 0, 1); G_STAGE(G_SB(0, 0), b2, voffB);
            G_BAR; G_WAIT_L(0); G_MMA(0, 1, At, B1); G_BAR;
            G_LDA(At, 0, 1); G_STAGE(G_SA(0, 0), a2, voffA);
            G_BAR; G_WAIT_L(0); G_MMA(1, 0, At, B0); G_BAR; G_SCHED;
            G_STAGE(G_SB(0, 1), b2 + hstep, voffB);
            G_WAIT_V(6); G_BAR; G_MMA(1, 1, At, B1); G_BAR;
            G_LDB(B0, 1, 0); G_SCHED; G_LDA(At, 1, 0); G_STAGE(G_SA(0, 1), a2 + hstep, voffA);
            G_WAIT_L(8); G_BAR; G_WAIT_L(0); G_MMA(0, 0, At, B0); G_BAR; G_SCHED;
            G_LDB(B1, 1, 1); G_STAGE(G_SB(1, 0), b3, voffB);
            G_BAR; G_WAIT_L(0); G_MMA(0, 1, At, B1); G_BAR;
            G_LDA(At, 1, 1); G_STAGE(G_SA(1, 0), a3, voffA);
            G_BAR; G_WAIT_L(0); G_MMA(1, 0, At, B0); G_BAR; G_SCHED;
            G_STAGE(G_SB(1, 1), b3 + hstep, voffB);
            G_WAIT_V(6); G_BAR; G_MMA(1, 1, At, B1); G_BAR;
        }
        E(acc, cur, wr, wc, fr, fq);
        if (!has_next) break;
#pragma unroll
        for (int a = 0; a < 2; ++a)
#pragma unroll
            for (int b = 0; b < 2; ++b)
#pragma unroll
                for (int m = 0; m < 4; ++m)
#pragma unroll
                    for (int n = 0; n < 2; ++n) acc[a][b][m][n] = (f32x4){0.f, 0.f, 0.f, 0.f};
        cur = nxt; cA = nA; cB = nB; ++ui;
    }
    G_WAIT_V(0);
    if (wr == 0) G_BAR;
    G_BAR;
#undef G_SA
#undef G_SB
#undef G_STAGE
#undef G_LDA
#undef G_LDB
#undef G_MMA
#undef G_WAIT_V
#undef G_WAIT_L
#undef G_BAR
#undef G_SCHED
}

__device__ __forceinline__ u32x4 pack8(const f32x4& v0, const f32x4& v1) {
    u32x4 r; r[0] = pk2(v0[0], v0[1]); r[1] = pk2(v0[2], v0[3]); r[2] = pk2(v1[0], v1[1]); r[3] = pk2(v1[2], v1[3]); return r;
}

struct SchedP2 {
    const char* H; const char* W; int G, c;
    __device__ bool next(int i, GUnit& u) const {
        const int L = i * G + c; if (L >= 136 * 16) return false;
        tile_of(L, 136, 16, u.pm, u.pn);
        u.A = H + (size_t)u.pm * 256 * LDK * 2; u.B = W + (size_t)u.pn * 256 * LDK * 2; u.nt = 16; u.kind = 0; return true;
    }
};
struct EpiP2 {
    bf16_t* ulru; bf16_t* aa; bf16_t* ufft; bf16_t* abc; bf16_t* upool;
    __device__ __forceinline__ void operator()(const f32x4 (&acc)[2][2][4][2], const GUnit& u, int wr, int wc, int fr, int fq) const {
        const int pn = u.pn; bf16_t* base; int ldc, colb; bool act;
        if (pn < 4) { base = ulru; ldc = 1024; colb = pn * 256; act = false; }
        else if (pn < 8) { base = aa; ldc = 1024; colb = (pn - 4) * 256; act = true; }
        else if (pn < 10) { base = ufft; ldc = 512; colb = (pn - 8) * 256; act = false; }
        else if (pn < 12) { base = abc; ldc = 1024; colb = (pn - 10) * 256; act = true; }
        else if (pn < 14) { base = upool; ldc = 512; colb = (pn - 12) * 256; act = false; }
        else { base = abc; ldc = 1024; colb = 512 + (pn - 14) * 256; act = true; }
        const int row0 = u.pm * 256 + wr * 64 + fr, col0 = colb + wc * 32 + 8 * fq;
#pragma unroll
        for (int ai = 0; ai < 2; ++ai)
#pragma unroll
            for (int m = 0; m < 4; ++m) {
                bf16_t* rowp = base + (size_t)(row0 + ai * 128 + m * 16) * ldc + col0;
#pragma unroll
                for (int bj = 0; bj < 2; ++bj) {
                    f32x4 v0 = acc[ai][bj][m][0], v1 = acc[ai][bj][m][1];
                    if (act) {
#pragma unroll
                        for (int j = 0; j < 4; ++j) { v0[j] = silu(v0[j]); v1[j] = silu(v1[j]); }
                    }
                    __builtin_nontemporal_store(pack8(v0, v1), (u32x4*)(rowp + bj * 128));
                }
            }
    }
};

struct SchedMerge {
    const char* H; const char* AA; const char* ABC; const char* WG; const char* PA; const char* PBC; int G, c, mode;
    __device__ bool next(int i, GUnit& u) const {
        const int task = i / 6, pos = i - task * 6; const int sub = (pos < 3) ? 2 * pos : 2 * (pos - 3) + 1;
        if (mode == 1) { const int L = task * G + c; if (L >= 512) return false; tile_of(L, 128, 4, u.pm, u.pn); }
        else if (mode == 2) { if (c >= 32 || task > 0) return false; u.pm = 128 + (c >> 2); u.pn = c & 3; }
        else return false;
        const size_t ao = (size_t)u.pm * 256 * LDK * 2, bo = (size_t)u.pn * 256 * LDK * 2;
        u.kind = sub;
        if ((sub & 1) == 0) { u.A = H + ao; u.B = WG + (size_t)(sub >> 1) * 1024 * LDK * 2 + bo; u.nt = 16; }
        else if (sub == 1) { u.A = AA + ao; u.B = PA + bo; u.nt = 16; }
        else if (sub == 3) { u.A = ABC + ao; u.B = PBC + bo; u.nt = 8; }
        else { u.A = ABC + ao + 1024; u.B = PBC + bo + 1024; u.nt = 8; }
        return true;
    }
};
struct EpiMerge {
    u32x4* gs;
    bf16_t* m;
    __device__ __forceinline__ void operator()(const f32x4 (&acc)[2][2][4][2], const GUnit& u, int wr, int wc, int fr, int fq) const {
        const int kind = u.kind; const int tid = threadIdx.x;
        const int row0 = u.pm * 256 + wr * 64 + fr, col0 = u.pn * 256 + wc * 32 + 8 * fq;
        if ((kind & 1) == 0) {
#pragma unroll
            for (int ai = 0; ai < 2; ++ai)
#pragma unroll
                for (int mm = 0; mm < 4; ++mm)
#pragma unroll
                    for (int bj = 0; bj < 2; ++bj) {
                        f32x4 v0 = acc[ai][bj][mm][0], v1 = acc[ai][bj][mm][1];
#pragma unroll
                        for (int j = 0; j < 4; ++j) { v0[j] = sigm(v0[j]); v1[j] = sigm(v1[j]); }
                        gs[(kind >> 1) * 8192 + ((ai * 4 + mm) * 2 + bj) * 512 + tid] = pack8(v0, v1);
                    }
        } else {
            const bool addold = (kind != 1);
#pragma unroll
            for (int am = 0; am < 4; ++am) {
                const int ai = am >> 1, mb = (am & 1) * 2;
                u32x4 gv[4], ov[4];
#pragma unroll
                for (int mi = 0; mi < 2; ++mi)
#pragma unroll
                    for (int bj = 0; bj < 2; ++bj) { const int mm = mb + mi;
                        gv[mi * 2 + bj] = gs[(kind >> 1) * 8192 + ((ai * 4 + mm) * 2 + bj) * 512 + tid];
                        ov[mi * 2 + bj] = (u32x4){0u, 0u, 0u, 0u};
                    }
                if (addold) {
#pragma unroll
                    for (int mi = 0; mi < 2; ++mi)
#pragma unroll
                        for (int bj = 0; bj < 2; ++bj) { const int mm = mb + mi;
                            ov[mi * 2 + bj] = *(const u32x4*)(m + (size_t)(row0 + ai * 128 + mm * 16) * 1024 + col0 + bj * 128); }
                }
#pragma unroll
                for (int mi = 0; mi < 2; ++mi)
#pragma unroll
                    for (int bj = 0; bj < 2; ++bj) { const int mm = mb + mi;
                        const u32x4 g = gv[mi * 2 + bj]; u32x4 o = ov[mi * 2 + bj];
                        if (!addold) o = (u32x4){0u, 0u, 0u, 0u};
                        const f32x4 v0 = acc[ai][bj][mm][0], v1 = acc[ai][bj][mm][1];
                        f32x4 r0, r1;
                        r0[0] = bflo(g[0]) * v0[0] + bflo(o[0]); r0[1] = bfhi(g[0]) * v0[1] + bfhi(o[0]); r0[2] = bflo(g[1]) * v0[2] + bflo(o[1]); r0[3] = bfhi(g[1]) * v0[3] + bfhi(o[1]);
                        r1[0] = bflo(g[2]) * v1[0] + bflo(o[2]); r1[1] = bfhi(g[2]) * v1[1] + bfhi(o[2]); r1[2] = bflo(g[3]) * v1[2] + bflo(o[3]); r1[3] = bfhi(g[3]) * v1[3] + bfhi(o[3]);
                        *(u32x4*)(m + (size_t)(row0 + ai * 128 + mm * 16) * 1024 + col0 + bj * 128) = pack8(r0, r1);
                    }
            }
        }
    }
};

struct SchedOut {
    const char* M; const char* W; int G, c, mode;
    __device__ bool next(int i, GUnit& u) const {
        if (mode == 1) { const int L = i * G + c; if (L >= 512) return false; tile_of(L, 128, 4, u.pm, u.pn); }
        else if (mode == 2) { if (c < 32) return false; const int L = i * (G - 32) + (c - 32); if (L >= 512) return false; tile_of(L, 128, 4, u.pm, u.pn); }
        else if (mode == 3) { if (c >= 32 || i > 0) return false; u.pm = 128 + (c >> 2); u.pn = c & 3; }
        else return false;
        u.A = M + (size_t)u.pm * 256 * LDK * 2; u.B = W + (size_t)u.pn * 256 * LDK * 2; u.nt = 16; u.kind = 0; return true;
    }
};
struct EpiOut {
    float* out; float* ctxres; const float* mod; float dryk;
    __device__ __forceinline__ void operator()(const f32x4 (&acc)[2][2][4][2], const GUnit& u, int wr, int wc, int fr, int fq) const {
        const int pm = u.pm; const bool lat = pm < 128; const int bb = lat ? (pm >> 4) : 8;
        float* base = lat ? out + (size_t)pm * 256 * 1024 : ctxres + (size_t)(pm - 128) * 256 * 1024;
        const float* gt = mod + bb * 3072 + 2048;
        const int r0 = wr * 64 + fr, col0 = u.pn * 256 + wc * 32 + 8 * fq;
#pragma unroll
        for (int bj = 0; bj < 2; ++bj) {
            const f32x4 g0 = *(const f32x4*)(gt + col0 + bj * 128) * dryk, g1 = *(const f32x4*)(gt + col0 + bj * 128 + 4) * dryk;
#pragma unroll
            for (int ai = 0; ai < 2; ++ai) {
                f32x4 o0[4], o1[4];
#pragma unroll
                for (int mm = 0; mm < 4; ++mm) { const float* rp = base + (size_t)(r0 + ai * 128 + mm * 16) * 1024 + col0 + bj * 128;
                    o0[mm] = *(const f32x4*)rp; o1[mm] = *(const f32x4*)(rp + 4); }
#pragma unroll
                for (int mm = 0; mm < 4; ++mm) { float* rp = base + (size_t)(r0 + ai * 128 + mm * 16) * 1024 + col0 + bj * 128;
                    *(f32x4*)rp = o0[mm] + g0 * acc[ai][bj][mm][0]; *(f32x4*)(rp + 4) = o1[mm] + g1 * acc[ai][bj][mm][1]; }
            }
        }
    }
};

__device__ void transpose_tile(const float* src, int ld_src, bf16_t* dst, int ld_dst, float* sT) {
    const int tid = tid_op(); const int nn = tid & 63, kk = tid >> 6;
#pragma unroll
    for (int i = 0; i < 8; ++i) { const int k = kk + 8 * i; sT[k * 65 + nn] = src[(size_t)k * ld_src + nn]; }
    __syncthreads();
    const int n = tid >> 3, k8 = tid & 7;
    u32x4 v;
#pragma unroll
    for (int j = 0; j < 4; ++j) v[j] = pk2(sT[(k8 * 8 + 2 * j) * 65 + n], sT[(k8 * 8 + 2 * j + 1) * 65 + n]);
    *(u32x4*)(dst + (size_t)n * ld_dst + k8 * 8) = v;
    __syncthreads();
}

__device__ void transpose_tile256(const float* src, int ld_src, bf16_t* dst, int ld_dst, float* sT) {
    const int tid = tid_op(); const int c4 = tid & 63, kk = tid >> 6;
    f32x4 v[8];
#pragma unroll
    for (int i = 0; i < 8; ++i) v[i] = *(const f32x4*)(src + (size_t)(kk + 8 * i) * ld_src + c4 * 4);
#pragma unroll
    for (int i = 0; i < 8; ++i) { float* d = sT + (kk + 8 * i) * 257 + c4 * 4; d[0] = v[i][0]; d[1] = v[i][1]; d[2] = v[i][2]; d[3] = v[i][3]; }
    __syncthreads();
#pragma unroll
    for (int i = 0; i < 4; ++i) { const int ch = tid + 512 * i, n = ch >> 3, k8 = ch & 7;
        u32x4 o;
#pragma unroll
        for (int j = 0; j < 4; ++j) o[j] = pk2(sT[(k8 * 8 + 2 * j) * 257 + n], sT[(k8 * 8 + 2 * j + 1) * 257 + n]);
        *(u32x4*)(dst + (size_t)n * ld_dst + k8 * 8) = o; }
    __syncthreads();
}

__device__ void phase0(const Params& p, unsigned char* smem) {
    unsigned char* ws = ptr_op(p.ws); const int tid = tid_op(); const int G = grd_op(), bid = bid_op();
    float* sT = (float*)smem;
    constexpr int B_WIN = 16 * 28, B_PA = 64, B_PB = 32, B_PC = 32, B_WO = 64, B_PER_L = B_WIN + B_PA + B_PB + B_PC + B_WO;
    for (int t = bid; t < 2 * B_PER_L; t += G) {
        const float* src; bf16_t* dst; int lds_;
        const int l = t / B_PER_L; int r = t - l * B_PER_L;
        if (r < B_WIN) { const int kt = r / 28, ntl = r % 28; src = p.w_in + (size_t)l * 1024 * INC + (size_t)kt * 64 * INC + ntl * 256; lds_ = INC;
            dst = (bf16_t*)(ws + WS_WINT) + (size_t)l * INC * 1024 + (size_t)ntl * 256 * 1024 + kt * 64; }
        else if ((r -= B_WIN) < B_PA) { const int kt = r / 4, ntl = r % 4; src = p.proj_a + (size_t)l * 1024 * 1024 + (size_t)kt * 64 * 1024 + ntl * 256; lds_ = 1024;
            dst = (bf16_t*)(ws + WS_PAT) + (size_t)l * 1024 * 1024 + (size_t)ntl * 256 * 1024 + kt * 64; }
        else if ((r -= B_PA) < B_PB) { const int kt = r / 4, ntl = r % 4; src = p.proj_b + (size_t)l * 512 * 1024 + (size_t)kt * 64 * 1024 + ntl * 256; lds_ = 1024;
            dst = (bf16_t*)(ws + WS_PBCT) + (size_t)l * 1024 * 1024 + (size_t)ntl * 256 * 1024 + kt * 64; }
        else if ((r -= B_PB) < B_PC) { const int kt = r / 4, ntl = r % 4; src = p.proj_c + (size_t)l * 512 * 1024 + (size_t)kt * 64 * 1024 + ntl * 256; lds_ = 1024;
            dst = (bf16_t*)(ws + WS_PBCT) + (size_t)l * 1024 * 1024 + (size_t)ntl * 256 * 1024 + 512 + kt * 64; }
        else { r -= B_PC; const int kt = r / 4, ntl = r % 4; src = p.w_out + (size_t)l * 1024 * 1024 + (size_t)kt * 64 * 1024 + ntl * 256; lds_ = 1024;
            dst = (bf16_t*)(ws + WS_WOT) + (size_t)l * 1024 * 1024 + (size_t)ntl * 256 * 1024 + kt * 64; }
        transpose_tile256(src, lds_, dst, 1024, sT);
    }
    constexpr int T_GATE = 128, T_POOL = 32;
    for (int t = bid; t < T_GATE + T_POOL; t += G) {
        const float* src; bf16_t* dst; int lds_, ldd; int r = t;
        if (r < T_GATE) { const int head = r & 15, gx = (r >> 4) & 1, dir = (r >> 5) & 1, l = r >> 6;
            src = (gx ? p.lru_wx : p.lru_wa) + ((size_t)((l * 2 + dir) * 16 + head)) * 4096; lds_ = 64;
            dst = (bf16_t*)(ws + WS_GATE) + ((size_t)(l * 16 + head) * 256 + (2 * dir + gx) * 64) * 64; ldd = 64; }
        else { r -= T_GATE; const int sub = r & 3, lg = r >> 2; const int kt = sub >> 1, ntl = sub & 1;
            src = p.pool_w + (size_t)lg * 128 * 128 + (size_t)kt * 64 * 128 + ntl * 64; lds_ = 128;
            dst = (bf16_t*)(ws + WS_POOLT) + (size_t)lg * 128 * 128 + (size_t)ntl * 64 * 128 + kt * 64; ldd = 128; }
        transpose_tile(src, lds_, dst, ldd, sT);
    }
    float* sTab = (float*)smem;
    __syncthreads();
    if (tid < 128) { sTab[tid] = __builtin_amdgcn_cosf((float)tid * (1.f / 128.f)); sTab[128 + tid] = __builtin_amdgcn_sinf((float)tid * (1.f / 128.f)); }
    __syncthreads();
    for (int idx = bid * 512 + tid; idx < 2 * 4 * 128 * 256; idx += G * 512) {
        const int k = idx & 255, n = (idx >> 8) & 127, lg = idx >> 15;
        const float* W = p.fft_w + (size_t)lg * 128 * 128 + n;
        const int kk = k & 127; const float* tab = sTab + (k >> 7) * 128;
        float s = 0.f;
        for (int m0 = 0; m0 < 128; m0 += 16) {
            float wv[16];
#pragma unroll
            for (int m = 0; m < 16; ++m) wv[m] = W[(m0 + m) * 128];
#pragma unroll
            for (int m = 0; m < 16; ++m) s += tab[(kk * (m0 + m)) & 127] * wv[m];
        }
        ((bf16_t*)(ws + WS_CWSW))[idx] = f2bf(s * 0.08838834764831845f);
    }
    for (int idx = bid * 512 + tid; idx < 128 * 64; idx += G * 512) {
        const int m = idx >> 6, k = idx & 63; const float rv = (float)(((m & 63) * k) & 63) * (1.f / 64.f); const float s = __builtin_amdgcn_sinf(rv), c = __builtin_amdgcn_cosf(rv);
        ((bf16_t*)(ws + WS_F1))[idx] = f2bf((m < 64 ? c : -s) * 0.125f);
    }
    for (int idx = bid * 512 + tid; idx < 128 * 128; idx += G * 512) {
        const int m = idx >> 7, k = idx & 127; const float rv = (float)(((m & 63) * (k & 63)) & 63) * (1.f / 64.f); const float s = __builtin_amdgcn_sinf(rv), c = __builtin_amdgcn_cosf(rv);
        float v; if (m < 64) v = (k < 64) ? c : s; else v = (k < 64) ? -s : c;
        ((bf16_t*)(ws + WS_G2))[idx] = f2bf(v * 0.125f);
    }
    for (int idx = bid * 512 + tid; idx < 4096; idx += G * 512) {
        const float s = __builtin_amdgcn_sinf((float)idx * (1.f / 4096.f)), c = __builtin_amdgcn_cosf((float)idx * (1.f / 4096.f));
        ((float*)(ws + WS_TW))[idx * 2] = c; ((float*)(ws + WS_TW))[idx * 2 + 1] = s;
    }
    for (int idx = bid * 512 + tid; idx < 64 * 512; idx += G * 512) {
        const int pp = idx >> 9, cidx = idx & 511, i = cidx & 255;
        const float omega = __builtin_amdgcn_exp2f(-(float)i * (13.287712379549449f / 256.f));
        const float rv = (float)pp * omega * 0.15915494309189535f;
        const float fr = rv - floorf(rv);
        ((float*)(ws + WS_POS))[idx] = (cidx < 256) ? __builtin_amdgcn_sinf(fr) : __builtin_amdgcn_cosf(fr);
    }
    for (int idx = bid * 512 + tid; idx < 2 * 2 * 1024; idx += G * 512) { const float e = __expf(-p.lru_lam[idx]); ((float*)(ws + WS_SP))[idx] = (e < 0.05f) ? e * (1.f + e * (-0.5f + e * ((1.f / 3.f) + e * (-0.25f + e * 0.2f)))) : __logf(1.f + e); }
    float* sS = (float*)smem;
    float* sR = sS + 9 * 1024;
    __syncthreads();
    for (int i = tid; i < 9 * 1024; i += 512) { const int bb = i >> 10, k = i & 1023; const float v = (bb < 8) ? p.c[bb * 1024 + k] : p.c_ctx[k]; sS[i] = silu(v); }
    __syncthreads();
    for (int t = bid; t < 96; t += G) {
        const int l = t / 48, n0 = (t % 48) * 64; const int nn = tid & 63, ks = tid >> 6;
        float a[9];
#pragma unroll
        for (int b = 0; b < 9; ++b) a[b] = 0.f;
        const float* W = p.ada_w + (size_t)l * 1024 * 3072 + n0 + nn;
        for (int k0 = ks * 128; k0 < ks * 128 + 128; k0 += 16) {
            float wv[16];
#pragma unroll
            for (int kk = 0; kk < 16; ++kk) wv[kk] = W[(size_t)(k0 + kk) * 3072];
#pragma unroll
            for (int kk = 0; kk < 16; ++kk)
#pragma unroll
                for (int b = 0; b < 9; ++b) a[b] += sS[b * 1024 + k0 + kk] * wv[kk];
        }
#pragma unroll
        for (int b = 0; b < 9; ++b) sR[(ks * 9 + b) * 64 + nn] = a[b];
        __syncthreads();
        for (int i = tid; i < 9 * 64; i += 512) { const int b = i >> 6, n = i & 63; float s = p.ada_b[l * 3072 + n0 + n];
#pragma unroll
            for (int k8 = 0; k8 < 8; ++k8) s += sR[(k8 * 9 + b) * 64 + n];
            ((float*)(ws + WS_MOD))[(size_t)(l * 9 + b) * 3072 + n0 + n] = s; }
        __syncthreads();
    }
}

__device__ void phase_norm(const Params& p, int l) {
    unsigned char* ws = ptr_op(p.ws); const int tid_ = tid_op(); const int lane = tid_ & 63, wid = tid_ >> 6;
    const float* mod = (const float*)(ws + WS_MOD) + (size_t)l * 9 * 3072;
    const float* g = p.norm_g + l * 1024; const float* pos = (const float*)(ws + WS_POS);
    bf16_t* H = (bf16_t*)(ws + WS_H); float* ctxres = (float*)(ws + WS_CTXRES);
    constexpr int NR = 4;
    for (int r0 = (bid_op() * 8 + wid) * NR; r0 < NT; r0 += grd_op() * 8 * NR) {
        const bool lat = r0 < NLAT; const int bb = lat ? (r0 >> 12) : 8;
        float* res = lat ? p.out + (size_t)r0 * 1024 : ctxres + (size_t)(r0 - NLAT) * 1024;
        f32x4 v[NR][4];
        if (l == 0) {
            const float* src = lat ? p.x + (size_t)r0 * 1024 : p.ctx + (size_t)(r0 - NLAT) * 1024;
#pragma unroll
            for (int rr = 0; rr < NR; ++rr)
#pragma unroll
                for (int i = 0; i < 4; ++i) v[rr][i] = *(const f32x4*)(src + rr * 1024 + i * 256 + lane * 4);
            if (lat) {
#pragma unroll
                for (int rr = 0; rr < NR; ++rr) { const int t = (r0 + rr) & 4095, gr = t >> 6, gc = t & 63;
#pragma unroll
                    for (int i = 0; i < 4; ++i) { const int col = i * 256 + lane * 4; const int pp = (col < 512) ? gr : gc; v[rr][i] += *(const f32x4*)(pos + pp * 512 + (col & 511)); } }
            }
#pragma unroll
            for (int rr = 0; rr < NR; ++rr)
#pragma unroll
                for (int i = 0; i < 4; ++i) __builtin_nontemporal_store(v[rr][i], (f32x4*)(res + rr * 1024 + i * 256 + lane * 4));
        } else {
#pragma unroll
            for (int rr = 0; rr < NR; ++rr)
#pragma unroll
                for (int i = 0; i < 4; ++i) v[rr][i] = *(const f32x4*)(res + rr * 1024 + i * 256 + lane * 4);
        }
        float rstd[NR];
#pragma unroll
        for (int rr = 0; rr < NR; ++rr) { float ss = 0.f;
#pragma unroll
            for (int i = 0; i < 4; ++i) ss += v[rr][i][0] * v[rr][i][0] + v[rr][i][1] * v[rr][i][1] + v[rr][i][2] * v[rr][i][2] + v[rr][i][3] * v[rr][i][3];
            ss = wave_sum(ss); rstd[rr] = rsqrtf(ss * (1.f / 1024.f) + 1e-6f); }
        const float* sh = mod + bb * 3072; const float* sc = sh + 1024;
#pragma unroll
        for (int i = 0; i < 4; ++i) { const int col = i * 256 + lane * 4;
            const f32x4 gg = *(const f32x4*)(g + col), s1 = *(const f32x4*)(sc + col) + 1.f, s0 = *(const f32x4*)(sh + col);
#pragma unroll
            for (int rr = 0; rr < NR; ++rr) {
                f32x4 y = (v[rr][i] * rstd[rr]) * gg; y = y * s1 + s0;
                u32x2 o; o[0] = pk2(y[0], y[1]); o[1] = pk2(y[2], y[3]);
                *(u32x2*)(H + (size_t)(r0 + rr) * 1024 + col) = o; } }
    }
}

__device__ void phase_final(const Params& p) {
    const int tid_ = tid_op(); const int lane = tid_ & 63, wid = tid_ >> 6;
    constexpr int NR = 4;
    const int stride = grd_op() * 8 * NR;
    f32x4 v[NR][4], vn[NR][4], gg[4];
#pragma unroll
    for (int i = 0; i < 4; ++i) gg[i] = *(const f32x4*)(p.final_g + i * 256 + lane * 4);
    int r0 = (bid_op() * 8 + wid) * NR;
    if (r0 < NLAT) {
#pragma unroll
        for (int rr = 0; rr < NR; ++rr)
#pragma unroll
            for (int i = 0; i < 4; ++i) v[rr][i] = *(const f32x4*)(p.out + (size_t)(r0 + rr) * 1024 + i * 256 + lane * 4); }
    while (r0 < NLAT) {
        const int rn = r0 + stride;
        if (rn < NLAT) {
#pragma unroll
            for (int rr = 0; rr < NR; ++rr)
#pragma unroll
                for (int i = 0; i < 4; ++i) vn[rr][i] = *(const f32x4*)(p.out + (size_t)(rn + rr) * 1024 + i * 256 + lane * 4); }
        float* res = p.out + (size_t)r0 * 1024;
        float rstd[NR];
#pragma unroll
        for (int rr = 0; rr < NR; ++rr) { float ss = 0.f;
#pragma unroll
            for (int i = 0; i < 4; ++i) ss += v[rr][i][0] * v[rr][i][0] + v[rr][i][1] * v[rr][i][1] + v[rr][i][2] * v[rr][i][2] + v[rr][i][3] * v[rr][i][3];
            ss = wave_sum(ss); rstd[rr] = rsqrtf(ss * (1.f / 1024.f) + 1e-6f); }
#pragma unroll
        for (int i = 0; i < 4; ++i) { const int col = i * 256 + lane * 4;
#pragma unroll
            for (int rr = 0; rr < NR; ++rr) __builtin_nontemporal_store((v[rr][i] * rstd[rr]) * gg[i], (f32x4*)(res + rr * 1024 + col)); }
#pragma unroll
        for (int rr = 0; rr < NR; ++rr)
#pragma unroll
            for (int i = 0; i < 4; ++i) v[rr][i] = vn[rr][i];
        r0 = rn;
    }
}

constexpr int LRU_SW = 0;
constexpr int LRU_SXB = 36864;
constexpr int LRU_SXF = LRU_SXB + 9216;
constexpr int LRU_SHF = LRU_SXF + 17408;
constexpr int LRU_SHB = LRU_SHF + 17408;

template <bool REV>
__device__ __forceinline__ void tile_scan(const float (&a)[4], const float (&b)[4], float (&h)[4], float& carry, float& atot, int c16) {
    float P[4], hl[4];
    if (!REV) { P[0] = a[0]; hl[0] = b[0];
#pragma unroll
        for (int j = 1; j < 4; ++j) { P[j] = a[j] * P[j - 1]; hl[j] = a[j] * hl[j - 1] + b[j]; } }
    else { P[3] = a[3]; hl[3] = b[3];
#pragma unroll
        for (int j = 2; j >= 0; --j) { P[j] = a[j] * P[j + 1]; hl[j] = a[j] * hl[j + 1] + b[j]; } }
    const float A4 = REV ? P[0] : P[3], H4 = REV ? hl[0] : hl[3];
    float Aq[4], Hq[4];
#pragma unroll
    for (int qq = 0; qq < 4; ++qq) { Aq[qq] = __shfl(A4, c16 + 16 * qq, 64); Hq[qq] = __shfl(H4, c16 + 16 * qq, 64); }
    const int q = (__lane_id()) >> 4;
    float S = carry, mine = carry;
#pragma unroll
    for (int s = 0; s < 4; ++s) { const int qq = REV ? 3 - s : s; if (q == qq) mine = S; S = Aq[qq] * S + Hq[qq]; atot *= Aq[qq]; }
    carry = S;
#pragma unroll
    for (int j = 0; j < 4; ++j) h[j] = hl[j] + P[j] * mine;
}

template <int PASS, bool REV>
__device__ __forceinline__ void lru_wave(const f32x4 (&acca)[4], const f32x4 (&accx)[4], const float* sXf, float* sHd, int ntile, int c16, int q,
                                         float nba, float nbx, float c8, float cin, float& aggA, float& aggH) {
    float carry = (PASS == 2) ? cin : 0.f, atot = 1.f;
#pragma unroll
    for (int s = 0; s < 4; ++s) {
        const int mt = REV ? 3 - s : s;
        float a[4], b[4], h[4];
#pragma unroll
        for (int j = 0; j < 4; ++j) {
            const int t = mt * 16 + 4 * q + j;
            const float xc = sXf[t * 68 + ntile * 16 + c16];
            const float r = __builtin_amdgcn_rcpf(1.f + __builtin_amdgcn_exp2f(fmaf(acca[mt][j], -1.4426950408889634f, nba)));
            const float ig = __builtin_amdgcn_rcpf(1.f + __builtin_amdgcn_exp2f(fmaf(accx[mt][j], -1.4426950408889634f, nbx)));
            const float x = c8 * r;
            float xq = x * (1.f + x * (-0.5f + x * ((1.f / 6.f) + x * ((-1.f / 24.f) + x * ((1.f / 120.f) + x * ((-1.f / 720.f) + x * (1.f / 5040.f)))))));
            if (x >= 0.25f) xq = 1.f - __expf(-x);
            a[j] = 1.f - xq;
            b[j] = __builtin_amdgcn_sqrtf(xq * (2.f - xq)) * (ig * xc);
        }
        tile_scan<REV>(a, b, h, carry, atot, c16);
        if (PASS == 2) {
#pragma unroll
            for (int j = 0; j < 4; ++j) sHd[(mt * 16 + 4 * q + j) * 68 + ntile * 16 + c16] = h[j];
        }
    }
    aggA = atot; aggH = carry;
}

constexpr int LRU_SCIN = LRU_SHB + 17408;

template <int PASS>
__device__ void phase_lru(const Params& p, int l, unsigned char* smem, bool dry = false) {
    unsigned char* ws = ptr_op(p.ws); const int tid = tid_op(), lane = tid & 63, wid = tid >> 6, c16 = lane & 15, q = lane >> 4;
    const int G = grd_op(); constexpr int NTASK = 16 * 8 * NCH;
    const int per = (NTASK + G - 1) / G; const int t_lo = bid_op() * per, t_hi = (t_lo + per < NTASK) ? t_lo + per : NTASK;
    bf16_t* sW = (bf16_t*)(smem + LRU_SW); bf16_t* sXb = (bf16_t*)(smem + LRU_SXB); float* sXf = (float*)(smem + LRU_SXF);
    float* sHf = (float*)(smem + LRU_SHF); float* sHb = (float*)(smem + LRU_SHB); float* sCin = (float*)(smem + LRU_SCIN);
    const bf16_t* ULRU = (const bf16_t*)(ws + WS_ULRU); bf16_t* AA = (bf16_t*)(ws + WS_AA);
    float* AGGA = (float*)(ws + WS_AGGA); float* AGGH = (float*)(ws + WS_AGGH);
    const float* SP = (const float*)(ws + WS_SP);
    const bool skipctx = (PASS == 2 && l == 1);
    const int d = wid >> 2, ntile = wid & 3;
    const int cc = tid & 63, tb = tid >> 6;
    int cur_head = -1, cur_hb = -1;
    float w0 = 0.f, w1 = 0.f, w2 = 0.f, w3 = 0.f, cb = 0.f, nba = 0.f, nbx = 0.f, c8 = 0.f;
    unsigned short uraw[11];
    auto first_valid = [&](int t) { if (skipctx && t < t_hi) { const int ch = t % NCH; if (ch < 4) t += 4 - ch; } return t; };
    auto load_u = [&](int task) {
        const int chunk = task % NCH, hb = task / NCH, b = hb & 7, head = hb >> 3;
        int rowbase, t0, seqlen;
        if (chunk < 4) { rowbase = NLAT + b * TCX; t0 = chunk * 64; seqlen = TCX; } else { rowbase = b * TL; t0 = (chunk - 4) * 64; seqlen = TL; }
#pragma unroll
        for (int i = 0; i < 11; ++i) { int tt = t0 + tb * 8 + i - 2; tt = tt < 0 ? 0 : (tt >= seqlen ? seqlen - 1 : tt);
            uraw[i] = ULRU[(size_t)(rowbase + tt) * 1024 + head * 64 + cc]; }
    };
    int task = first_valid(t_lo);
    if (task < t_hi) load_u(task);
    while (task < t_hi) {
        const int chunk = task % NCH, hb = task / NCH, b = hb & 7, head = hb >> 3;
        int rowbase, t0, seqlen_c;
        if (chunk < 4) { rowbase = NLAT + b * TCX; t0 = chunk * 64; seqlen_c = TCX; } else { rowbase = b * TL; t0 = (chunk - 4) * 64; seqlen_c = TL; }
        if (head != cur_head) {
            const bf16_t* Wg = (const bf16_t*)(ws + WS_GATE) + (size_t)(l * 16 + head) * 256 * 64;
#pragma unroll
            for (int i = 0; i < 4; ++i) { const int ch = tid + 512 * i, row = ch >> 3, c8i = ch & 7;
                *(u32x4*)(sW + row * 72 + c8i * 8) = *(const u32x4*)(Wg + row * 64 + c8i * 8); }
            const float* cw = p.conv_w + (size_t)l * 4 * 1024 + head * 64 + cc;
            w0 = cw[0]; w1 = cw[1024]; w2 = cw[2048]; w3 = cw[3072]; cb = p.conv_b[l * 1024 + head * 64 + cc];
            const int chg = (l * 2 + d) * 1024 + head * 64 + ntile * 16 + c16;
            nba = -1.4426950408889634f * p.lru_ba[chg]; nbx = -1.4426950408889634f * p.lru_bx[chg]; c8 = 8.f * SP[chg];
            cur_head = head;
        }
        if (PASS == 2 && hb != cur_hb) {
            if (tid < 128) {
                const int ch = tid & 63, dd = tid >> 6;
                const size_t base = (size_t)(b * 2 + dd) * NCH * 1024 + head * 64 + ch;
                float av[NCH], hv[NCH];
#pragma unroll
                for (int k = 0; k < NCH; ++k) { av[k] = AGGA[base + (size_t)k * 1024]; hv[k] = AGGH[base + (size_t)k * 1024]; }
                float s = 0.f; float* sc = sCin + dd * NCH * 64 + ch;
                if (dd == 0) {
#pragma unroll
                    for (int k = 0; k < NCH; ++k) { sc[k * 64] = s; s = av[k] * s + hv[k]; }
                } else {
#pragma unroll
                    for (int k = 3; k >= 0; --k) { sc[k * 64] = s; s = av[k] * s + hv[k]; }
#pragma unroll
                    for (int k = NCH - 1; k >= 4; --k) { sc[k * 64] = s; s = av[k] * s + hv[k]; }
                }
            }
            cur_hb = hb;
        }
        u32x4 szraw = (u32x4){0u, 0u, 0u, 0u};
        bf16_t* aap = AA + (size_t)(rowbase + t0 + (tid >> 3)) * 1024 + head * 64 + (tid & 7) * 8;
        if (PASS == 2) szraw = *(const u32x4*)aap;
        float uu[11];
#pragma unroll
        for (int i = 0; i < 11; ++i) { const int tt = t0 + tb * 8 + i - 2; uu[i] = (tt >= 0 && tt < seqlen_c) ? bf2f(uraw[i]) : 0.f; }
#pragma unroll
        for (int i = 0; i < 8; ++i) { const float xc = cb + w0 * uu[i] + w1 * uu[i + 1] + w2 * uu[i + 2] + w3 * uu[i + 3];
            const int t = tb * 8 + i; sXf[t * 68 + cc] = xc; sXb[t * 72 + cc] = f2bf(xc); }
        const int nxt = first_valid(task + 1);
        if (nxt < t_hi) load_u(nxt);
        lds_barrier();
        {
            f32x4 acca[4], accx[4];
#pragma unroll
            for (int mt = 0; mt < 4; ++mt) { acca[mt] = (f32x4){0.f, 0.f, 0.f, 0.f}; accx[mt] = (f32x4){0.f, 0.f, 0.f, 0.f}; }
            const int na = (2 * d) * 64 + ntile * 16, nx = (2 * d + 1) * 64 + ntile * 16;
#pragma unroll
            for (int ks = 0; ks < 2; ++ks) {
                const bf16x8 fa = *(const bf16x8*)(sW + (na + c16) * 72 + ks * 32 + q * 8);
                const bf16x8 fx = *(const bf16x8*)(sW + (nx + c16) * 72 + ks * 32 + q * 8);
#pragma unroll
                for (int mt = 0; mt < 4; ++mt) {
                    const bf16x8 xa = *(const bf16x8*)(sXb + (mt * 16 + c16) * 72 + ks * 32 + q * 8);
                    acca[mt] = __builtin_amdgcn_mfma_f32_16x16x32_bf16(xa, fa, acca[mt], 0, 0, 0);
                    accx[mt] = __builtin_amdgcn_mfma_f32_16x16x32_bf16(xa, fx, accx[mt], 0, 0, 0);
                }
            }
            const float cin = (PASS == 2) ? sCin[(d * NCH + chunk) * 64 + ntile * 16 + c16] : 0.f;
            float aggA, aggH;
            if (d == 0) lru_wave<PASS, false>(acca, accx, sXf, sHf, ntile, c16, q, nba, nbx, c8, cin, aggA, aggH);
            else lru_wave<PASS, true>(acca, accx, sXf, sHb, ntile, c16, q, nba, nbx, c8, cin, aggA, aggH);
            if (PASS == 1 && q == 0) { const size_t cidx = ((size_t)(b * 2 + d) * NCH + chunk) * 1024 + head * 64 + ntile * 16 + c16; AGGA[cidx] = aggA; AGGH[cidx] = aggH; }
        }
        if (PASS == 2) {
            lds_barrier();
            { const int t = tid >> 3, c8 = (tid & 7) * 8;
              const f32x4 f0 = *(const f32x4*)(sHf + t * 68 + c8), f1 = *(const f32x4*)(sHf + t * 68 + c8 + 4);
              const f32x4 b0 = *(const f32x4*)(sHb + t * 68 + c8), b1 = *(const f32x4*)(sHb + t * 68 + c8 + 4);
              f32x4 y0 = f0 + b0, y1 = f1 + b1;
              y0[0] *= bflo(szraw[0]); y0[1] *= bfhi(szraw[0]); y0[2] *= bflo(szraw[1]); y0[3] *= bfhi(szraw[1]);
              y1[0] *= bflo(szraw[2]); y1[1] *= bfhi(szraw[2]); y1[2] *= bflo(szraw[3]); y1[3] *= bfhi(szraw[3]);
              *(u32x4*)aap = dry ? szraw : pack8(y0, y1); }
        }
        lds_barrier();
        task = nxt;
    }
}

constexpr int LP1_SXB = 36864;
constexpr int LP1_SXF = LP1_SXB + 18432;
__device__ void phase_lru_p1(const Params& p, int l, unsigned char* smem) {
    unsigned char* ws = ptr_op(p.ws); const int tid = tid_op(), lane = tid & 63, wid = tid >> 6, c16 = lane & 15, q = lane >> 4;
    const int G = grd_op(); constexpr int NPAIR = 16 * 8 * (NCH / 2);
    const int per = (NPAIR + G - 1) / G; const int p_lo = bid_op() * per, p_hi = (p_lo + per < NPAIR) ? p_lo + per : NPAIR;
    bf16_t* sW = (bf16_t*)(smem + LRU_SW); bf16_t* sXb = (bf16_t*)(smem + LP1_SXB); float* sXf = (float*)(smem + LP1_SXF);
    const bf16_t* ULRU = (const bf16_t*)(ws + WS_ULRU);
    float* AGGA = (float*)(ws + WS_AGGA); float* AGGH = (float*)(ws + WS_AGGH);
    const float* SP = (const float*)(ws + WS_SP);
    const int d = wid >> 2, ntile = wid & 3;
    const int cc = tid & 63, tb = tid >> 6;
    int cur_head = -1;
    float w0 = 0.f, w1 = 0.f, w2 = 0.f, w3 = 0.f, cb = 0.f, nba = 0.f, nbx = 0.f, c8 = 0.f;
    unsigned short uraw[19];
    auto load_u = [&](int pi) {
        const int pc = pi % (NCH / 2), hb = pi / (NCH / 2), b = hb & 7, head = hb >> 3, chunk = 2 * pc;
        int rowbase, t0, seqlen;
        if (chunk < 4) { rowbase = NLAT + b * TCX; t0 = chunk * 64; seqlen = TCX; } else { rowbase = b * TL; t0 = (chunk - 4) * 64; seqlen = TL; }
#pragma unroll
        for (int i = 0; i < 19; ++i) { int tt = t0 + tb * 16 + i - 2; tt = tt < 0 ? 0 : (tt >= seqlen ? seqlen - 1 : tt);
            uraw[i] = ULRU[(size_t)(rowbase + tt) * 1024 + head * 64 + cc]; }
    };
    int pi = p_lo;
    if (pi < p_hi) load_u(pi);
    while (pi < p_hi) {
        const int pc = pi % (NCH / 2), hb = pi / (NCH / 2), b = hb & 7, head = hb >> 3, chunk = 2 * pc;
        int t0, seqlen_c;
        if (chunk < 4) { t0 = chunk * 64; seqlen_c = TCX; } else { t0 = (chunk - 4) * 64; seqlen_c = TL; }
        if (head != cur_head) {
            const bf16_t* Wg = (const bf16_t*)(ws + WS_GATE) + (size_t)(l * 16 + head) * 256 * 64;
#pragma unroll
            for (int i = 0; i < 4; ++i) { const int ch = tid + 512 * i, row = ch >> 3, c8i = ch & 7;
                *(u32x4*)(sW + row * 72 + c8i * 8) = *(const u32x4*)(Wg + row * 64 + c8i * 8); }
            const float* cw = p.conv_w + (size_t)l * 4 * 1024 + head * 64 + cc;
            w0 = cw[0]; w1 = cw[1024]; w2 = cw[2048]; w3 = cw[3072]; cb = p.conv_b[l * 1024 + head * 64 + cc];
            const int chg = (l * 2 + d) * 1024 + head * 64 + ntile * 16 + c16;
            nba = -1.4426950408889634f * p.lru_ba[chg]; nbx = -1.4426950408889634f * p.lru_bx[chg]; c8 = 8.f * SP[chg];
            cur_head = head;
        }
        {
            float uu[19];
#pragma unroll
            for (int i = 0; i < 19; ++i) { const int tt = t0 + tb * 16 + i - 2; uu[i] = (tt >= 0 && tt < seqlen_c) ? bf2f(uraw[i]) : 0.f; }
#pragma unroll
            for (int i = 0; i < 16; ++i) { const float xc = cb + w0 * uu[i] + w1 * uu[i + 1] + w2 * uu[i + 2] + w3 * uu[i + 3];
                const int t = tb * 16 + i; sXf[t * 68 + cc] = xc; sXb[t * 72 + cc] = f2bf(xc); }
        }
        const int nxt = pi + 1;
        if (nxt < p_hi) load_u(nxt);
        lds_barrier();
        {
            f32x4 acca0[4], accx0[4], acca1[4], accx1[4];
#pragma unroll
            for (int mt = 0; mt < 4; ++mt) { acca0[mt] = (f32x4){0.f, 0.f, 0.f, 0.f}; accx0[mt] = (f32x4){0.f, 0.f, 0.f, 0.f}; acca1[mt] = (f32x4){0.f, 0.f, 0.f, 0.f}; accx1[mt] = (f32x4){0.f, 0.f, 0.f, 0.f}; }
            const int na = (2 * d) * 64 + ntile * 16, nx = (2 * d + 1) * 64 + ntile * 16;
#pragma unroll
            for (int ks = 0; ks < 2; ++ks) {
                const bf16x8 fa = *(const bf16x8*)(sW + (na + c16) * 72 + ks * 32 + q * 8);
                const bf16x8 fx = *(const bf16x8*)(sW + (nx + c16) * 72 + ks * 32 + q * 8);
#pragma unroll
                for (int mt = 0; mt < 4; ++mt) {
                    const bf16x8 xa = *(const bf16x8*)(sXb + (mt * 16 + c16) * 72 + ks * 32 + q * 8);
                    const bf16x8 xb = *(const bf16x8*)(sXb + (64 + mt * 16 + c16) * 72 + ks * 32 + q * 8);
                    acca0[mt] = __builtin_amdgcn_mfma_f32_16x16x32_bf16(xa, fa, acca0[mt], 0, 0, 0);
                    accx0[mt] = __builtin_amdgcn_mfma_f32_16x16x32_bf16(xa, fx, accx0[mt], 0, 0, 0);
                    acca1[mt] = __builtin_amdgcn_mfma_f32_16x16x32_bf16(xb, fa, acca1[mt], 0, 0, 0);
                    accx1[mt] = __builtin_amdgcn_mfma_f32_16x16x32_bf16(xb, fx, accx1[mt], 0, 0, 0);
                }
            }
            float aA0, aH0, aA1, aH1;
            if (d == 0) { lru_wave<1, false>(acca0, accx0, sXf, nullptr, ntile, c16, q, nba, nbx, c8, 0.f, aA0, aH0);
                          lru_wave<1, false>(acca1, accx1, sXf + 64 * 68, nullptr, ntile, c16, q, nba, nbx, c8, 0.f, aA1, aH1); }
            else        { lru_wave<1, true>(acca0, accx0, sXf, nullptr, ntile, c16, q, nba, nbx, c8, 0.f, aA0, aH0);
                          lru_wave<1, true>(acca1, accx1, sXf + 64 * 68, nullptr, ntile, c16, q, nba, nbx, c8, 0.f, aA1, aH1); }
            if (q == 0) { const size_t cidx = ((size_t)(b * 2 + d) * NCH + chunk) * 1024 + head * 64 + ntile * 16 + c16;
                AGGA[cidx] = aA0; AGGH[cidx] = aH0; AGGA[cidx + 1024] = aA1; AGGH[cidx + 1024] = aH1; }
        }
        lds_barrier();
        pi = nxt;
    }
}

typedef short s16x4 __attribute__((ext_vector_type(4)));
__device__ __forceinline__ bf16x8 tr_bfrag(const bf16_t* tile, int ld, int krow0, int c0, int c16) {
    const int qq = c16 >> 2, pp = c16 & 3;
    const bf16_t* a0 = tile + (krow0 + qq) * ld + c0 + 4 * pp;
    const s16x4 v0 = __builtin_amdgcn_ds_read_tr16_b64_v4i16((LAS s16x4*)a0);
    const s16x4 v1 = __builtin_amdgcn_ds_read_tr16_b64_v4i16((LAS s16x4*)(a0 + 4 * ld));
    bf16x8 r; r[0] = v0[0]; r[1] = v0[1]; r[2] = v0[2]; r[3] = v0[3]; r[4] = v1[0]; r[5] = v1[1]; r[6] = v1[2]; r[7] = v1[3];
    return r;
}

constexpr int F1_SF = 0;
constexpr int F1_SB = 18432;
constexpr int F1_SO = F1_SB + 33280;
constexpr int F1_TW = F1_SO + 67584;
__device__ void phase_fft1(const Params& p, unsigned char* smem) {
    unsigned char* ws = ptr_op(p.ws); const int tid = tid_op(), lane = tid & 63, wid = tid >> 6, c16 = lane & 15, q = lane >> 4;
    bf16_t* sF = (bf16_t*)(smem + F1_SF); bf16_t* sB = (bf16_t*)(smem + F1_SB); bf16_t* sO = (bf16_t*)(smem + F1_SO); float* sTW = (float*)(smem + F1_TW);
    const bf16_t* UF = (const bf16_t*)(ws + WS_UFFT); bf16_t* APR = (bf16_t*)(ws + WS_APR); const float* TW = (const float*)(ws + WS_TW);
    const bf16_t* F1 = (const bf16_t*)(ws + WS_F1);
    const int NTASK = NB * 64 * 2, G = grd_op();
#pragma unroll
    for (int i = 0; i < 2; ++i) { const int ch = tid + 512 * i, row = ch >> 3, c8 = ch & 7; *(u32x4*)(sF + row * 72 + c8 * 8) = *(const u32x4*)(F1 + row * 64 + c8 * 8); }
    u32x4 tile[4]; float twv = 0.f;
    auto load_tile = [&](int task) {
        const int jh = task & 1, t2 = (task >> 1) & 63, b = task >> 7;
#pragma unroll
        for (int i = 0; i < 4; ++i) { const int ch = tid + 512 * i, t1 = ch >> 5, cc = ch & 31;
            tile[i] = *(const u32x4*)(UF + ((size_t)(b * TL + 64 * t1 + t2)) * 512 + jh * 256 + cc * 8); }
        twv = TW[(((tid & 127) >> 1) * t2) * 2 + (tid & 1)];
    };
    int task = bid_op();
    if (task < NTASK) load_tile(task);
    while (task < NTASK) {
        const int jh = task & 1, t2 = (task >> 1) & 63, b = task >> 7;
        if (tid < 128) sTW[tid] = twv;
#pragma unroll
        for (int i = 0; i < 4; ++i) { const int ch = tid + 512 * i, t1 = ch >> 5, cc = ch & 31;
            u32x2* dp = (u32x2*)(sB + t1 * 260 + cc * 8); u32x2 lo, hi; lo[0] = tile[i][0]; lo[1] = tile[i][1]; hi[0] = tile[i][2]; hi[1] = tile[i][3]; dp[0] = lo; dp[1] = hi; }
        const int nxt = task + G;
        if (nxt < NTASK) load_tile(nxt);
        lds_barrier();
#pragma unroll
        for (int ntl = 0; ntl < 2; ++ntl) {
            const int nt = wid * 2 + ntl;
            bf16x8 bfr[2];
#pragma unroll
            for (int ks = 0; ks < 2; ++ks) bfr[ks] = tr_bfrag(sB, 260, ks * 32 + q * 8, nt * 16, c16);
#pragma unroll
            for (int mtp = 0; mtp < 4; ++mtp) {
                f32x4 are = (f32x4){0.f, 0.f, 0.f, 0.f}, aim = (f32x4){0.f, 0.f, 0.f, 0.f};
#pragma unroll
                for (int ks = 0; ks < 2; ++ks) {
                    const bf16x8 fre = *(const bf16x8*)(sF + (mtp * 16 + c16) * 72 + ks * 32 + q * 8);
                    const bf16x8 fim = *(const bf16x8*)(sF + (64 + mtp * 16 + c16) * 72 + ks * 32 + q * 8);
                    are = __builtin_amdgcn_mfma_f32_16x16x32_bf16(fre, bfr[ks], are, 0, 0, 0);
                    aim = __builtin_amdgcn_mfma_f32_16x16x32_bf16(fim, bfr[ks], aim, 0, 0, 0);
                }
#pragma unroll
                for (int j = 0; j < 4; ++j) {
                    const int k1 = mtp * 16 + 4 * q + j, n = nt * 16 + c16;
                    const float tc = sTW[k1 * 2], ts = sTW[k1 * 2 + 1];
                    sO[(k1 * 2) * 264 + n] = f2bf(are[j] * tc + aim[j] * ts);
                    sO[(k1 * 2 + 1) * 264 + n] = f2bf(aim[j] * tc - are[j] * ts);
                }
            }
        }
        lds_barrier();
#pragma unroll
        for (int i = 0; i < 8; ++i) { const int ch = tid + 512 * i, row = ch >> 5, cc = ch & 31;
            *(u32x4*)(APR + (((size_t)(b * 64) * 2 + row) * 64 + t2) * 512 + jh * 256 + cc * 8) = *(const u32x4*)(sO + row * 264 + cc * 8); }
        task = nxt;
    }
    lds_barrier();
}

template <int NMT>
__device__ __forceinline__ void fft_stage3_load(const Params& p, int l, int g, int rowbase, int rowstride, bf16x8 (&bfr)[8], float (&oldv)[NMT][4]) {
    const int tid_ = tid_op(); const int lane = tid_ & 63, wid = tid_ >> 6, c16 = lane & 15, q = lane >> 4;
    const bf16_t* CW = (const bf16_t*)(p.ws + WS_CWSW) + ((size_t)(l * 4 + g) * 128 + wid * 16 + c16) * 256;
    const bf16_t* ABC = (const bf16_t*)(p.ws + WS_ABC);
#pragma unroll
    for (int ks = 0; ks < 8; ++ks) bfr[ks] = *(const bf16x8*)(CW + ks * 32 + q * 8);
#pragma unroll
    for (int mt = 0; mt < NMT; ++mt)
#pragma unroll
        for (int j = 0; j < 4; ++j) oldv[mt][j] = bf2f(ABC[(size_t)(rowbase + rowstride * (mt * 16 + 4 * q + j)) * 1024 + g * 128 + wid * 16 + c16]);
}
template <int NMT>
__device__ __forceinline__ void fft_stage3_mma(const Params& p, int g, const bf16_t* sA3, int rowbase, int rowstride, const bf16x8 (&bfr)[8], const float (&oldv)[NMT][4], bool dry) {
    const int tid_ = tid_op(); const int lane = tid_ & 63, wid = tid_ >> 6, c16 = lane & 15, q = lane >> 4;
    bf16_t* ABC = (bf16_t*)(p.ws + WS_ABC);
#pragma unroll
    for (int mt = 0; mt < NMT; ++mt) {
        f32x4 acc = (f32x4){0.f, 0.f, 0.f, 0.f};
#pragma unroll
        for (int ks = 0; ks < 8; ++ks) { const bf16x8 a = *(const bf16x8*)(sA3 + (mt * 16 + c16) * 264 + ks * 32 + q * 8);
            acc = __builtin_amdgcn_mfma_f32_16x16x32_bf16(a, bfr[ks], acc, 0, 0, 0); }
#pragma unroll
        for (int j = 0; j < 4; ++j) { const int mrow = mt * 16 + 4 * q + j;
            ABC[(size_t)(rowbase + rowstride * mrow) * 1024 + g * 128 + wid * 16 + c16] = f2bf(dry ? oldv[mt][j] : acc[j] * oldv[mt][j]); }
    }
}

__device__ __forceinline__ void fft_stage3v_load(const Params& p, int l, int g, int rowbase, bf16x8 (&bfr)[8], u32x4 (&oldr)[2]) {
    const int tid_ = tid_op(); const int lane = tid_ & 63, wid = tid_ >> 6, c16 = lane & 15, q = lane >> 4;
    const bf16_t* CW = (const bf16_t*)(p.ws + WS_CWSW) + ((size_t)(l * 4 + g) * 128 + wid * 16 + c16) * 256;
    const bf16_t* ap = (const bf16_t*)(p.ws + WS_ABC) + (size_t)(rowbase + 64 * (tid_ >> 3)) * 1024 + g * 128 + (tid_ & 7) * 16;
#pragma unroll
    for (int ks = 0; ks < 8; ++ks) bfr[ks] = *(const bf16x8*)(CW + ks * 32 + q * 8);
    oldr[0] = *(const u32x4*)ap; oldr[1] = *(const u32x4*)(ap + 8);
}
__device__ __forceinline__ void fft_stage3v_mma(const bf16_t* sA3, bf16_t* sOut, const bf16x8 (&bfr)[8]) {
    const int tid_ = tid_op(); const int lane = tid_ & 63, wid = tid_ >> 6, c16 = lane & 15, q = lane >> 4;
#pragma unroll
    for (int mt = 0; mt < 4; ++mt) {
        f32x4 acc = (f32x4){0.f, 0.f, 0.f, 0.f};
#pragma unroll
        for (int ks = 0; ks < 8; ++ks) { const bf16x8 a = *(const bf16x8*)(sA3 + (mt * 16 + c16) * 264 + ks * 32 + q * 8);
            acc = __builtin_amdgcn_mfma_f32_16x16x32_bf16(a, bfr[ks], acc, 0, 0, 0); }
#pragma unroll
        for (int j = 0; j < 4; ++j) ((float*)sOut)[(mt * 16 + 4 * q + j) * 132 + wid * 16 + c16] = acc[j];
    }
}
__device__ __forceinline__ void fft_stage3v_store(const Params& p, int g, const bf16_t* sOut, int rowbase, const u32x4 (&oldr)[2]) {
    const int tid_ = tid_op(); const int row = tid_ >> 3, cb = (tid_ & 7) * 16;
    bf16_t* ap = (bf16_t*)(p.ws + WS_ABC) + (size_t)(rowbase + 64 * row) * 1024 + g * 128 + cb;
    const float* so = (const float*)sOut + row * 132 + cb;
#pragma unroll
    for (int h = 0; h < 2; ++h) {
        f32x4 y0 = *(const f32x4*)(so + h * 8), y1 = *(const f32x4*)(so + h * 8 + 4);
        const u32x4 o = oldr[h];
        y0[0] *= bflo(o[0]); y0[1] *= bfhi(o[0]); y0[2] *= bflo(o[1]); y0[3] *= bfhi(o[1]);
        y1[0] *= bflo(o[2]); y1[1] *= bfhi(o[2]); y1[2] *= bflo(o[3]); y1[3] *= bfhi(o[3]);
        *(u32x4*)(ap + h * 8) = pack8(y0, y1);
    }
}

constexpr int F2_SG = 0;
constexpr int F2_SB = 34816;
constexpr int F2_SA3 = F2_SB + 33792;
constexpr int F2_SO = F2_SA3 + 33792;
__device__ void phase_fft23(const Params& p, int l, unsigned char* smem, bool dry = false) {
    unsigned char* ws = ptr_op(p.ws); const int tid = tid_op(), lane = tid & 63, wid = tid >> 6, c16 = lane & 15, q = lane >> 4;
    bf16_t* sG = (bf16_t*)(smem + F2_SG); bf16_t* sB = (bf16_t*)(smem + F2_SB); bf16_t* sA3 = (bf16_t*)(smem + F2_SA3); bf16_t* sOut = (bf16_t*)(smem + F2_SO);
    const bf16_t* APR = (const bf16_t*)(ws + WS_APR); const bf16_t* G2 = (const bf16_t*)(ws + WS_G2);
    const int NTASK = NB * 64 * 4, G = grd_op();
#pragma unroll
    for (int i = 0; i < 4; ++i) { const int ch = tid + 512 * i, row = ch >> 4, cc = ch & 15; *(u32x4*)(sG + row * 136 + cc * 8) = *(const u32x4*)(G2 + row * 128 + cc * 8); }
    u32x4 tile[4];
    auto load_tile = [&](int task) {
        const int g = task & 3, k1 = (task >> 2) & 63, b = task >> 8;
#pragma unroll
        for (int i = 0; i < 4; ++i) { const int ch = tid + 512 * i, row = ch >> 4, cc = ch & 15;
            tile[i] = *(const u32x4*)(APR + ((size_t)(b * 64 + k1) * 128 + row) * 512 + g * 128 + cc * 8); }
    };
    int task = bid_op();
    if (task < NTASK) load_tile(task);
    while (task < NTASK) {
        const int g = task & 3, k1 = (task >> 2) & 63, b = task >> 8;
        bf16x8 bfr3[8]; u32x4 oldr3[2];
        fft_stage3v_load(p, l, g, b * TL + k1, bfr3, oldr3);
#pragma unroll
        for (int i = 0; i < 4; ++i) { const int ch = tid + 512 * i, row = ch >> 4, cc = ch & 15;
            u32x2* dp = (u32x2*)(sB + row * 132 + cc * 8); u32x2 lo, hi; lo[0] = tile[i][0]; lo[1] = tile[i][1]; hi[0] = tile[i][2]; hi[1] = tile[i][3]; dp[0] = lo; dp[1] = hi; }
        const int nxt = task + G;
        if (nxt < NTASK) load_tile(nxt);
        lds_barrier();
        {
            bf16x8 bfr[4];
#pragma unroll
            for (int ks = 0; ks < 4; ++ks) bfr[ks] = tr_bfrag(sB, 132, ks * 32 + q * 8, wid * 16, c16);
#pragma unroll
            for (int mt = 0; mt < 8; ++mt) {
                f32x4 acc = (f32x4){0.f, 0.f, 0.f, 0.f};
#pragma unroll
                for (int ks = 0; ks < 4; ++ks) { const bf16x8 a = *(const bf16x8*)(sG + (mt * 16 + c16) * 136 + ks * 32 + q * 8);
                    acc = __builtin_amdgcn_mfma_f32_16x16x32_bf16(a, bfr[ks], acc, 0, 0, 0); }
#pragma unroll
                for (int j = 0; j < 4; ++j) { const int m = mt * 16 + 4 * q + j, cp = m >> 6, k2 = m & 63;
                    sA3[k2 * 264 + cp * 128 + wid * 16 + c16] = f2bf(acc[j]); }
            }
        }
        lds_barrier();
        fft_stage3v_mma(sA3, sOut, bfr3);
        lds_barrier();
        fft_stage3v_store(p, g, sOut, b * TL + k1, oldr3);
        task = nxt;
    }
    lds_barrier();
}

constexpr int FC_SU = 0;
constexpr int FC_TAB = 65536;
constexpr int FC_SA3 = 67584;
__device__ void phase_fftctx(const Params& p, int l, unsigned char* smem, bool dry = false) {
    unsigned char* ws = ptr_op(p.ws); const int tid = tid_op();
    bf16_t* sU = (bf16_t*)(smem + FC_SU); float* sTab = (float*)(smem + FC_TAB); bf16_t* sA3 = (bf16_t*)(smem + FC_SA3);
    const bf16_t* UF = (const bf16_t*)(ws + WS_UFFT);
    for (int task = bid_op(); task < NB * 16 * 4; task += grd_op()) {
        const int g = task & 3, kb = (task >> 2) & 15, b = task >> 6;
        bf16x8 bfr3[8]; float oldv3[1][4];
        fft_stage3_load<1>(p, l, g, NLAT + b * TCX + kb * 16, 1, bfr3, oldv3);
        if (tid < 256) { sTab[tid * 2] = __builtin_amdgcn_cosf((float)tid * (1.f / 256.f)); sTab[tid * 2 + 1] = __builtin_amdgcn_sinf((float)tid * (1.f / 256.f)); }
#pragma unroll
        for (int i = 0; i < 8; ++i) { const int ch = tid + 512 * i, t = ch >> 4, cc = ch & 15;
            *(u32x4*)(sU + t * 128 + cc * 8) = *(const u32x4*)(UF + ((size_t)(NLAT + b * TCX + t)) * 512 + g * 128 + cc * 8); }
        __syncthreads();
        {
            const int j = tid & 127, kq = tid >> 7; const int kbase = kb * 16 + kq * 4;
            float re[4], im[4] = {0.f, 0.f, 0.f, 0.f};
            { const float u0 = bf2f(sU[j]), u128 = bf2f(sU[128 * 128 + j]);
#pragma unroll
              for (int i = 0; i < 4; ++i) re[i] = ((kbase + i) & 1) ? u0 - u128 : u0 + u128; }
            for (int t = 1; t < 128; ++t) {
                const float ua = bf2f(sU[t * 128 + j]), ub = bf2f(sU[(256 - t) * 128 + j]);
                const float us = ua + ub, ud = ua - ub;
#pragma unroll
                for (int i = 0; i < 4; ++i) { const int idx = ((kbase + i) * t) & 255; re[i] += sTab[idx * 2] * us; im[i] -= sTab[idx * 2 + 1] * ud; }
            }
#pragma unroll
            for (int i = 0; i < 4; ++i) { sA3[(kq * 4 + i) * 264 + j] = f2bf(re[i] * 0.0625f); sA3[(kq * 4 + i) * 264 + 128 + j] = f2bf(im[i] * 0.0625f); }
        }
        __syncthreads();
        fft_stage3_mma<1>(p, g, sA3, NLAT + b * TCX + kb * 16, 1, bfr3, oldv3, dry);
        __syncthreads();
    }
}

constexpr int PL_SU = 0;
constexpr int PL_SP = 40960;
constexpr int PL_SO = PL_SP + 17408;
__device__ void phase_pool(const Params& p, int l, unsigned char* smem, bool dry = false) {
    unsigned char* ws = ptr_op(p.ws); const int tid = tid_op(), lane = tid & 63, wid = tid >> 6, c16 = lane & 15, q = lane >> 4;
    float* sU = (float*)(smem + PL_SU); bf16_t* sP = (bf16_t*)(smem + PL_SP); float* sO = (float*)(smem + PL_SO);
    const bf16_t* UP = (const bf16_t*)(ws + WS_UPOOL); bf16_t* ABC = (bf16_t*)(ws + WS_ABC);
    const int ntask = 2048 + (l == 0 ? 128 : 0), G = grd_op();
    auto decode = [&](int task, int& g, int& t0, int& rowbase, int& seqlen) {
        if (task < 2048) { g = task & 3; t0 = ((task >> 2) & 63) * 64; rowbase = (task >> 8) * TL; seqlen = TL; }
        else { const int r = task - 2048; g = r & 3; t0 = ((r >> 2) & 3) * 64; rowbase = NLAT + (r >> 4) * TCX; seqlen = TCX; }
    };
    u32x4 vv[3];
    auto load_tile = [&](int task) {
        int g, t0, rowbase, seqlen; decode(task, g, t0, rowbase, seqlen);
#pragma unroll
        for (int i = 0; i < 3; ++i) { int ch = tid + 512 * i; ch = ch < 80 * 16 ? ch : 80 * 16 - 1;
            const int r = ch >> 4, cc = ch & 15, tt = t0 - 8 + r;
            const int ttc = tt < 0 ? 0 : (tt >= seqlen ? seqlen - 1 : tt);
            vv[i] = *(const u32x4*)(UP + (size_t)(rowbase + ttc) * 512 + g * 128 + cc * 8); }
    };
    int task = bid_op();
    if (task < ntask) load_tile(task);
    while (task < ntask) {
        int g, t0, rowbase, seqlen; decode(task, g, t0, rowbase, seqlen);
        const bf16_t* PW = (const bf16_t*)(ws + WS_POOLT) + ((size_t)(l * 4 + g) * 128 + wid * 16 + c16) * 128;
        bf16x8 bfr[4];
#pragma unroll
        for (int ks = 0; ks < 4; ++ks) bfr[ks] = *(const bf16x8*)(PW + ks * 32 + q * 8);
        const float scl = p.pool_scale[l * 512 + g * 128 + wid * 16 + c16];
        bf16_t* aop = ABC + (size_t)(rowbase + t0 + (tid >> 3)) * 1024 + 512 + g * 128 + (tid & 7) * 16;
        u32x4 oldr[2]; oldr[0] = *(const u32x4*)aop; oldr[1] = *(const u32x4*)(aop + 8);
#pragma unroll
        for (int i = 0; i < 3; ++i) { const int ch = tid + 512 * i;
            if (ch < 80 * 16) { const int r = ch >> 4, cc = ch & 15, tt = t0 - 8 + r;
                u32x4 v = vv[i];
                if (!(tt >= 0 && tt < seqlen)) v = (u32x4){0u, 0u, 0u, 0u};
                f32x4 f0, f1; f0[0] = bflo(v[0]); f0[1] = bfhi(v[0]); f0[2] = bflo(v[1]); f0[3] = bfhi(v[1]); f1[0] = bflo(v[2]); f1[1] = bfhi(v[2]); f1[2] = bflo(v[3]); f1[3] = bfhi(v[3]);
                *(f32x4*)(sU + r * 128 + cc * 8) = f0; *(f32x4*)(sU + r * 128 + cc * 8 + 4) = f1; } }
        const int nxt = task + G;
        if (nxt < ntask) load_tile(nxt);
        lds_barrier();
        {
            const int j = tid & 127, tq = tid >> 7; const int half = 1 << g;
            for (int i = 0; i < 16; ++i) { const int t = tq * 16 + i, pos = t0 + t;
                const int lo = (pos - half > 0) ? pos - half : 0, hi = (pos + half < seqlen) ? pos + half : seqlen;
                float s = 0.f;
                for (int r = t + 8 - half; r < t + 8 + half; ++r) s += sU[r * 128 + j];
                const float pv = s / (float)(hi - lo) - sU[(t + 8) * 128 + j];
                sP[t * 136 + j] = f2bf(pv); }
        }
        lds_barrier();
        {
#pragma unroll
            for (int mt = 0; mt < 4; ++mt) {
                f32x4 acc = (f32x4){0.f, 0.f, 0.f, 0.f};
#pragma unroll
                for (int ks = 0; ks < 4; ++ks) { const bf16x8 a = *(const bf16x8*)(sP + (mt * 16 + c16) * 136 + ks * 32 + q * 8);
                    acc = __builtin_amdgcn_mfma_f32_16x16x32_bf16(a, bfr[ks], acc, 0, 0, 0); }
#pragma unroll
                for (int j = 0; j < 4; ++j) sO[(mt * 16 + 4 * q + j) * 132 + wid * 16 + c16] = acc[j] * scl;
            }
        }
        lds_barrier();
        { const float* so = sO + (tid >> 3) * 132 + (tid & 7) * 16;
#pragma unroll
          for (int h = 0; h < 2; ++h) {
              f32x4 y0 = *(const f32x4*)(so + h * 8), y1 = *(const f32x4*)(so + h * 8 + 4);
              const u32x4 o = oldr[h];
              y0[0] *= bflo(o[0]); y0[1] *= bfhi(o[0]); y0[2] *= bflo(o[1]); y0[3] *= bfhi(o[1]);
              y1[0] *= bflo(o[2]); y1[1] *= bfhi(o[2]); y1[2] *= bflo(o[3]); y1[3] *= bfhi(o[3]);
              *(u32x4*)(aop + h * 8) = dry ? o : pack8(y0, y1); } }
        task = nxt;
    }
    lds_barrier();
}

#define XB_TMO      128
#define XB_XCNT(j)  (256  + 64 * (j))
#define XB_XSUB(j)  (1280 + 64 * (j))
#define XB_XGEN(j)  (2304 + 64 * (j))
#define XB_TOP      3328
#define XB_TOPGEN   3392
#define XCD_BAR_WORDS 3456
#define XB_SPIN_CAP (1u << 18)
__device__ __forceinline__ unsigned xb_ld(unsigned* p)              { return __hip_atomic_load(p, __ATOMIC_RELAXED, __HIP_MEMORY_SCOPE_AGENT); }
__device__ __forceinline__ unsigned xb_add(unsigned* p, unsigned v) { return __hip_atomic_fetch_add(p, v, __ATOMIC_RELAXED, __HIP_MEMORY_SCOPE_AGENT); }
__device__ __forceinline__ unsigned xb_xcc_id() { return (unsigned)__builtin_amdgcn_s_getreg((3 << 11) | 20) & 0xFu; }
#define XB_SPIN(cond, bar) do { unsigned _sp = 0; while (cond) { __builtin_amdgcn_s_sleep(1); \
    if ((++_sp & 255u) == 0u) { if (xb_ld(&(bar)[XB_TMO])) break; if (_sp > XB_SPIN_CAP) { atomicAdd(&(bar)[XB_TMO], 1u); break; } } } } while (0)
struct XcdBarrier { unsigned* bar; unsigned x; volatile LAS unsigned* st; };
__device__ __forceinline__ XcdBarrier xcd_barrier_post(unsigned* bar, volatile LAS unsigned* st) {
    XcdBarrier b; b.bar = bar; b.x = xb_xcc_id(); b.st = st;
    if (threadIdx.x == 0) (void)xb_add(&bar[XB_XCNT(b.x)], 1u);
    return b;
}
__device__ __forceinline__ void xcd_barrier_complete(unsigned* bar, unsigned x, unsigned& nloc, unsigned& nx) {
    const unsigned G = gridDim.x * gridDim.y * gridDim.z;
    unsigned sum, cnt, mine, sp = 0u;
    for (;;) {
        sum = 0u; cnt = 0u; mine = 0u;
#pragma unroll
        for (unsigned j = 0; j < 16; ++j) { const unsigned c = xb_ld(&bar[XB_XCNT(j)]); sum += c; cnt += (c > 0u) ? 1u : 0u; mine = (j == x) ? c : mine; }
        if (sum == G) break;
        __builtin_amdgcn_s_sleep(1);
        if ((++sp & 255u) == 0u) { if (xb_ld(&bar[XB_TMO])) break; if (sp > XB_SPIN_CAP) { atomicAdd(&bar[XB_TMO], 1u); break; } }
    }
    nloc = mine > 0u ? mine : 1u; nx = cnt > 0u ? cnt : 1u;
}
__device__ __forceinline__ void xcd_barrier(const XcdBarrier& b) {
    asm volatile("s_waitcnt vmcnt(0)" ::: "memory");
    __syncthreads();
    if (threadIdx.x == 0) {
        unsigned* bar = b.bar;
        __builtin_amdgcn_s_waitcnt(0);
        unsigned nloc = b.st[0], nx = b.st[1];
        if (nloc == 0u) { xcd_barrier_complete(bar, b.x, nloc, nx); b.st[0] = nloc; b.st[1] = nx; }
        const unsigned old = xb_add(&bar[XB_XSUB(b.x)], 1u);
        const unsigned gen = old / nloc;
        if (old + 1u == (gen + 1u) * nloc) {
            __builtin_amdgcn_fence(__ATOMIC_RELEASE, "agent");
            asm volatile("s_waitcnt vmcnt(0)" ::: "memory");
            const unsigned og = xb_add(&bar[XB_TOP], 1u);
            const unsigned tg = og / nx;
            if (og + 1u == (tg + 1u) * nx) xb_add(&bar[XB_TOPGEN], 1u);
            else XB_SPIN(xb_ld(&bar[XB_TOPGEN]) == tg, bar);
            __builtin_amdgcn_fence(__ATOMIC_ACQUIRE, "agent");
            xb_add(&bar[XB_XGEN(b.x)], 1u);
            asm volatile("s_waitcnt vmcnt(0)" ::: "memory");
        } else {
            XB_SPIN(xb_ld(&bar[XB_XGEN(b.x)]) == gen, bar);
            __builtin_amdgcn_fence(__ATOMIC_ACQUIRE, "agent");
            asm volatile("s_waitcnt vmcnt(0)" ::: "memory");
        }
    }
    __syncthreads();
}

__global__ void __launch_bounds__(512, 2) fwd_megakernel(Params p_unused) {
    extern __shared__ __attribute__((aligned(16))) unsigned char smem[];
    cg::grid_group grid = cg::this_grid();

    LAS unsigned char* lds = (LAS unsigned char*)smem;
    const int G = grd_op(), bid = bid_op();

    if (threadIdx.x == 0) { *(u32x4*)(smem + LDS_ST) = (u32x4){0u, 0u, 0u, 0u}; }
    __syncthreads();
    const XcdBarrier xb = xcd_barrier_post((unsigned*)(kparams().ws + WS_BAR), (volatile LAS unsigned*)(lds + LDS_ST));
    phase0(kparams(), smem);
    grid.sync();
    for (int l = 0; l < 2; ++l) {
        const bool last = (l == 1);
        phase_norm(kparams(), l);
        xcd_barrier(xb);
        {
            unsigned char* ws = kparams().ws;
            SchedP2 S; S.H = (const char*)(ws + WS_H); S.W = (const char*)(ws + WS_WINT) + (size_t)l * INC * 1024 * 2; S.G = G; S.c = bid;
            EpiP2 E; E.ulru = (bf16_t*)(ws + WS_ULRU); E.aa = (bf16_t*)(ws + WS_AA); E.ufft = (bf16_t*)(ws + WS_UFFT); E.abc = (bf16_t*)(ws + WS_ABC); E.upool = (bf16_t*)(ws + WS_UPOOL);
            gemm_stream(lds, S, E);
        }
        xcd_barrier(xb);
        phase_lru_p1(kparams(), l, smem);
        phase_fft1(kparams(), smem);
        if (!last) phase_fftctx(kparams(), l, smem);
        phase_pool(kparams(), l, smem);
        xcd_barrier(xb);
        phase_lru<2>(kparams(), l, smem);
        phase_fft23(kparams(), l, smem);
        xcd_barrier(xb);
        const int nsteps = last ? 2 : 3;
#pragma unroll 1
        for (int step = 0; step < nsteps; ++step) {
            {
                unsigned char* ws = kparams().ws;
                SchedMerge S; S.H = (const char*)(ws + WS_H); S.AA = (const char*)(ws + WS_AA); S.ABC = (const char*)(ws + WS_ABC);
                S.WG = (const char*)(ws + WS_WINT) + ((size_t)l * INC + 4096) * 1024 * 2; S.PA = (const char*)(ws + WS_PAT) + (size_t)l * 1024 * 1024 * 2;
                S.PBC = (const char*)(ws + WS_PBCT) + (size_t)l * 1024 * 1024 * 2; S.G = G; S.c = bid; S.mode = (step == 0) ? 1 : ((step == 1 && !last) ? 2 : 0);
                EpiMerge E; E.gs = (u32x4*)(ws + WS_UFFT + (size_t)bid * 393216); E.m = (bf16_t*)(ws + WS_ULRU);
                gemm_stream(lds, S, E);
            }
            {
                unsigned char* ws = kparams().ws;
                SchedOut S; S.M = (const char*)(ws + WS_ULRU); S.W = (const char*)(ws + WS_WOT) + (size_t)l * 1024 * 1024 * 2; S.G = G; S.c = bid;
                S.mode = (step == 0) ? 0 : (step == 1 ? (last ? 1 : 2) : 3);
                EpiOut E; E.out = kparams().out; E.ctxres = (float*)(ws + WS_CTXRES); E.mod = (const float*)(ws + WS_MOD) + (size_t)l * 9 * 3072; E.dryk = 1.f;
                gemm_stream(lds, S, E);
            }
            xcd_barrier(xb);
        }
    }
    phase_final(kparams());
}

extern "C" void kernel_launch(void* const* d_in, const int* in_sizes, int n_in, void* d_out, int out_size, void* d_ws, size_t ws_size, hipStream_t stream) {
    static int grid_blocks = 0;
    if (grid_blocks == 0) {
        if (n_in != 23 || ws_size < WS_END) { fprintf(stderr, "kernel_launch: unexpected n_in %d or ws_size %zu < %zu\n", n_in, ws_size, (size_t)WS_END); grid_blocks = -1; return; }
        int dev = 0, cus = 0, per_cu = 0;
        hipGetDevice(&dev);
        hipDeviceGetAttribute(&cus, hipDeviceAttributeMultiprocessorCount, dev);
        hipFuncSetAttribute((const void*)fwd_megakernel, hipFuncAttributeMaxDynamicSharedMemorySize, LDS_BYTES);
        hipOccupancyMaxActiveBlocksPerMultiprocessor(&per_cu, (const void*)fwd_megakernel, 512, LDS_BYTES);
        if (per_cu < 1) { fprintf(stderr, "kernel_launch: occupancy query says %d blocks per CU\n", per_cu); per_cu = 1; }
        grid_blocks = cus * 1;
        fprintf(stderr, "kernel_launch: cus %d per_cu %d grid %d ws %zu need %zu\n", cus, per_cu, grid_blocks, ws_size, (size_t)WS_END);
    }
    if (grid_blocks < 0) return;
    if (hipMemsetAsync((char*)d_ws + WS_BAR, 0, XCD_BAR_WORDS_C * 4, stream) != hipSuccess) { fprintf(stderr, "kernel_launch: memset failed\n"); return; }
    Params p{};
    const float** f = (const float**)&p;
    for (int i = 0; i < 23; ++i) f[i] = (const float*)d_in[i];
    p.out = (float*)d_out; p.ws = (unsigned char*)d_ws;
    void* args[] = {&p};
    hipError_t e = hipLaunchCooperativeKernel((const void*)fwd_megakernel, dim3(grid_blocks), dim3(512), args, LDS_BYTES, stream);
    if (e != hipSuccess) fprintf(stderr, "cooperative launch failed: %s (grid %d)\n", hipGetErrorString(e), grid_blocks);
}
```

```cpp
#include <hip/hip_runtime.h>
#include <hip/hip_cooperative_groups.h>
#include <cstdio>
namespace cg = cooperative_groups;

#define LAS __attribute__((address_space(3)))
typedef unsigned short bf16_t;
typedef short bf16x8 __attribute__((ext_vector_type(8)));
typedef float f32x4 __attribute__((ext_vector_type(4)));
typedef unsigned u32x4 __attribute__((ext_vector_type(4)));
typedef unsigned u32x2 __attribute__((ext_vector_type(2)));

constexpr int NB = 8, TL = 4096, TCX = 256, DM = 1024;
constexpr int NLAT = NB * TL, NCTX = NB * TCX, NT = NLAT + NCTX;
constexpr int INC = 7168;
constexpr int NCH = 68;
constexpr int LDS_ST = 139264;
constexpr int LDS_BYTES = LDS_ST + 256;
constexpr int XCD_BAR_WORDS_C = 3456;

constexpr size_t al256(size_t x) { return (x + 255) & ~(size_t)255; }
constexpr size_t WS_WINT = 0;
constexpr size_t WS_PAT = WS_WINT + al256((size_t)2 * INC * 1024 * 2);
constexpr size_t WS_PBCT = WS_PAT + al256((size_t)2 * 1024 * 1024 * 2);
constexpr size_t WS_WOT = WS_PBCT + al256((size_t)2 * 1024 * 1024 * 2);
constexpr size_t WS_GATE = WS_WOT + al256((size_t)2 * 1024 * 1024 * 2);
constexpr size_t WS_POOLT = WS_GATE + al256((size_t)2 * 16 * 256 * 64 * 2);
constexpr size_t WS_CWSW = WS_POOLT + al256((size_t)2 * 4 * 128 * 128 * 2);
constexpr size_t WS_F1 = WS_CWSW + al256((size_t)2 * 4 * 128 * 256 * 2);
constexpr size_t WS_G2 = WS_F1 + al256((size_t)128 * 64 * 2);
constexpr size_t WS_TW = WS_G2 + al256((size_t)128 * 128 * 2);
constexpr size_t WS_POS = WS_TW + al256((size_t)4096 * 2 * 4);
constexpr size_t WS_MOD = WS_POS + al256((size_t)64 * 512 * 4);
constexpr size_t WS_SP = WS_MOD + al256((size_t)2 * 9 * 3072 * 4);
constexpr size_t WS_H = WS_SP + al256((size_t)2 * 2 * 1024 * 4);
constexpr size_t WS_ULRU = WS_H + al256((size_t)NT * 1024 * 2);
constexpr size_t WS_AA = WS_ULRU + al256((size_t)NT * 1024 * 2);
constexpr size_t WS_ABC = WS_AA + al256((size_t)NT * 1024 * 2);
constexpr size_t WS_UFFT = WS_ABC + al256((size_t)NT * 1024 * 2);
constexpr size_t WS_UPOOL = WS_UFFT + al256((size_t)NT * 512 * 2);
constexpr size_t WS_APR = WS_UPOOL + al256((size_t)NT * 512 * 2);
constexpr size_t WS_CTXRES = WS_APR + al256((size_t)NB * 64 * 2 * 64 * 512 * 2);
constexpr size_t WS_AGGA = WS_CTXRES + al256((size_t)NCTX * 1024 * 4);
constexpr size_t WS_AGGH = WS_AGGA + al256((size_t)NB * 2 * NCH * 1024 * 4);
constexpr size_t WS_CIN = WS_AGGH + al256((size_t)NB * 2 * NCH * 1024 * 4);
constexpr size_t WS_BAR = WS_CIN + al256((size_t)NB * 2 * NCH * 1024 * 4);
constexpr size_t WS_END = WS_BAR + al256((size_t)XCD_BAR_WORDS_C * 4);

struct Params {
    const float* x; const float* c; const float* ctx; const float* c_ctx; const float* norm_g; const float* ada_w; const float* ada_b; const float* w_in;
    const float* conv_w; const float* conv_b; const float* lru_wa; const float* lru_ba; const float* lru_wx; const float* lru_bx; const float* lru_lam;
    const float* fft_w; const float* pool_w; const float* pool_scale; const float* proj_a; const float* proj_b; const float* proj_c; const float* w_out; const float* final_g;
    float* out; unsigned char* ws;
};

__device__ __forceinline__ const Params& kparams() { const __attribute__((address_space(4))) void* k = (const __attribute__((address_space(4))) void*)__builtin_amdgcn_kernarg_segment_ptr(); asm volatile("" : "+s"(k)); return *(const Params*)k; }
typedef float f32x2_t __attribute__((ext_vector_type(2)));
typedef __bf16 bf16x2_t __attribute__((ext_vector_type(2)));
__device__ __forceinline__ unsigned pk2(float lo, float hi) { f32x2_t v = {lo, hi}; bf16x2_t b = __builtin_convertvector(v, bf16x2_t); return __builtin_bit_cast(unsigned, b); }
__device__ __forceinline__ bf16_t f2bf(float f) { return (bf16_t)(pk2(f, 0.f) & 0xFFFFu); }
__device__ __forceinline__ float bf2f(bf16_t b) { return __uint_as_float(((unsigned)b) << 16); }
__device__ __forceinline__ float bflo(unsigned u) { return __uint_as_float(u << 16); }
__device__ __forceinline__ float bfhi(unsigned u) { return __uint_as_float(u & 0xFFFF0000u); }
__device__ __forceinline__ float sigm(float x) { return __fdividef(1.f, 1.f + __expf(-x)); }
__device__ __forceinline__ float silu(float x) { return __fdividef(x, 1.f + __expf(-x)); }
__device__ __forceinline__ float wave_sum(float v) {
#pragma unroll
    for (int o = 32; o > 0; o >>= 1) v += __shfl_xor(v, o, 64);
    return v;
}

__device__ __forceinline__ void lds_barrier() { asm volatile("s_waitcnt lgkmcnt(0)\n\ts_barrier" ::: "memory"); }
__device__ __forceinline__ int tid_op() { int t = threadIdx.x; asm volatile("" : "+v"(t)); return t; }
__device__ __forceinline__ int bid_op() { int t = __builtin_amdgcn_readfirstlane((int)blockIdx.x); asm volatile("" : "+s"(t)); return t; }
__device__ __forceinline__ int grd_op() { int t = __builtin_amdgcn_readfirstlane((int)gridDim.x); asm volatile("" : "+s"(t)); return t; }
__device__ __forceinline__ unsigned char* ptr_op(unsigned char* q) { unsigned lo = __builtin_amdgcn_readfirstlane((unsigned)(size_t)q), hi = __builtin_amdgcn_readfirstlane((unsigned)((size_t)q >> 32)); asm volatile("" : "+s"(lo), "+s"(hi)); return (unsigned char*)(((size_t)hi << 32) | lo); }

constexpr int BM = 256, BK = 64, HALF = 128, HTB = HALF * BK * 2, NXCD = 8, WGM = 8, LDK = 1024;
__device__ __forceinline__ int lds_byte(int r, int c) { const int st = (r >> 4) * 2 + (c >> 5), rr = r & 15, cc = c & 31, ob = rr * 64 + cc * 2; return st * 1024 + (ob ^ (((ob >> 9) & 1) << 5)); }
__device__ __forceinline__ void stage_rc(int b, int& R, int& C) { const int st = b / 1024, sb = b % 1024, swz = sb ^ (((sb >> 9) & 1) << 5); R = (st >> 1) * 16 + swz / 64; C = (st & 1) * 32 + (swz % 64) / 2; }
__device__ __forceinline__ int perm32(int rho) { const int n = rho >> 4, i = rho & 15; return 8 * (i >> 2) + 4 * n + (i & 3); }

struct GUnit { const char* A; const char* B; int nt; int kind; int pm; int pn; };

__device__ __forceinline__ void tile_of(int L, int nM, int nN, int& pm, int& pn) {
    const int nwg = nM * nN; int wgid = L;
    { const int q = nwg / NXCD, r = nwg % NXCD, xcd = wgid % NXCD, off = wgid / NXCD; wgid = (xcd < r ? xcd * (q + 1) : r * (q + 1) + (xcd - r) * q) + off; }
    const int nig = WGM * nN, gid = wgid / nig, fm = gid * WGM, gsz = (nM - fm) < WGM ? (nM - fm) : WGM;
    pm = fm + ((wgid % nig) % gsz); pn = (wgid % nig) / gsz;
}

template <class Sched, class Epi>
__device__ __forceinline__ void gemm_stream(LAS unsigned char* lds, const Sched& S, const Epi& E) {
    const int tid = tid_op(), wid = __builtin_amdgcn_readfirstlane(tid >> 6), lane = tid & 63, wr = wid >> 2, wc = wid & 3, fr = lane & 15, fq = lane >> 4;
    unsigned voffA[2], voffB[2];
#pragma unroll
    for (int i = 0; i < 2; ++i) { int R, C; stage_rc(tid * 16 + i * 8192, R, C); const int Rb = (R & ~31) + perm32(R & 31);
        voffA[i] = (unsigned)(R * LDK + C) * 2u; voffB[i] = (unsigned)(Rb * LDK + C) * 2u; }
    const size_t kstep = (size_t)(BK * 2);
    const size_t hstep = (size_t)HALF * LDK * 2;
    const unsigned ldsw = (unsigned)wid * 1024u;
    const int aoff = lds_byte(wr * 64 + fr, fq * 8), boff = lds_byte(wc * 32 + fr, fq * 8);
#define G_SA(b, h) (((b) * 2 + (h)) * HTB)
#define G_SB(b, h) ((4 + (b) * 2 + (h)) * HTB)
#define G_STAGE(bufoff, gbase, voff) do { _Pragma("unroll") for (int _i = 0; _i < 2; ++_i) \
        __builtin_amdgcn_global_load_lds((const unsigned*)((const char*)(gbase) + (voff)[_i]), (LAS unsigned*)(lds + (bufoff) + ldsw + _i * 8192), 16, 0, 0); } while (0)
#define G_LDA(dst, b, h) do { _Pragma("unroll") for (int m = 0; m < 4; ++m) _Pragma("unroll") for (int k = 0; k < 2; ++k) dst[m][k] = *(const LAS bf16x8*)(lds + G_SA(b, h) + aoff + m * 2048 + k * 1024); } while (0)
#define G_LDB(dst, b, h) do { _Pragma("unroll") for (int n = 0; n < 2; ++n) _Pragma("unroll") for (int k = 0; k < 2; ++k) dst[n][k] = *(const LAS bf16x8*)(lds + G_SB(b, h) + boff + n * 2048 + k * 1024); } while (0)
#define G_MMA(ai, bj, At, Bt) do { __builtin_amdgcn_s_setprio(1); _Pragma("unroll") for (int m = 0; m < 4; ++m) _Pragma("unroll") for (int n = 0; n < 2; ++n) _Pragma("unroll") for (int k = 0; k < 2; ++k) \
        acc[ai][bj][m][n] = __builtin_amdgcn_mfma_f32_16x16x32_bf16(Bt[n][k], At[m][k], acc[ai][bj][m][n], 0, 0, 0); __builtin_amdgcn_s_setprio(0); } while (0)
#define G_WAIT_V(n) asm volatile("s_waitcnt vmcnt(" #n ")" ::: "memory")
#define G_WAIT_L(n) asm volatile("s_waitcnt lgkmcnt(" #n ")" ::: "memory")
#define G_BAR __builtin_amdgcn_s_barrier()
#define G_SCHED __builtin_amdgcn_sched_barrier(0)
    GUnit cur, nxt; int ui = 0;
    if (!S.next(0, cur)) return;
    f32x4 acc[2][2][4][2];
#pragma unroll
    for (int a = 0; a < 2; ++a)
#pragma unroll
        for (int b = 0; b < 2; ++b)
#pragma unroll
            for (int m = 0; m < 4; ++m)
#pragma unroll
                for (int n = 0; n < 2; ++n) acc[a][b][m][n] = (f32x4){0.f, 0.f, 0.f, 0.f};
    bf16x8 At[4][2], B0[2][2], B1[2][2];
    const char* cA = cur.A; const char* cB = cur.B;
    G_STAGE(G_SB(0, 0), cB, voffB); G_STAGE(G_SA(0, 0), cA, voffA); G_STAGE(G_SB(0, 1), cB + hstep, voffB); G_STAGE(G_SA(0, 1), cA + hstep, voffA);
    if (wr == 1) G_BAR;
    G_WAIT_V(4); G_BAR;
    G_STAGE(G_SB(1, 0), cB + kstep, voffB); G_STAGE(G_SA(1, 0), cA + kstep, voffA); G_STAGE(G_SB(1, 1), cB + hstep + kstep, voffB);
    G_WAIT_V(6); G_BAR;
    for (;;) {
        const bool has_next = S.next(ui + 1, nxt);
        const char* nA = has_next ? nxt.A : cA; const char* nB = has_next ? nxt.B : cB;
        const int nt = cur.nt;
        for (int t = 0; t < nt; t += 2) {
            const bool last = (t == nt - 2);
            const char* a1 = cA + (size_t)(t + 1) * kstep;
            const char* a2 = last ? nA : cA + (size_t)(t + 2) * kstep; const char* b2 = last ? nB : cB + (size_t)(t + 2) * kstep;
            const char* a3 = a2 + kstep; const char* b3 = b2 + kstep;
            G_LDB(B0, 0, 0); G_SCHED; G_LDA(At, 0, 0); G_STAGE(G_SA(1, 1), a1 + hstep, voffA);
            G_WAIT_L(8); G_BAR; G_WAIT_L(0); G_MMA(0, 0, At, B0); G_BAR; G_SCHED;
            G_LDB(B1, 0, 1); G_STAGE(G_SB(0, 0), b2, voffB);
            G_BAR; G_WAIT_L(0); G_MMA(0, 1, At, B1); G_BAR;
            G_LDA(At, 0, 1); G_STAGE(G_SA(0, 0), a2, voffA);
            G_BAR; G_WAIT_L(0); G_MMA(1, 0, At, B0); G_BAR; G_SCHED;
            G_STAGE(G_SB(0, 1), b2 + hstep, voffB);
            G_WAIT_V(6); G_BAR; G_MMA(1, 1, At, B1); G_BAR;
            G_LDB(B0, 1, 0); G_SCHED; G_LDA(At, 1, 0); G_STAGE(G_SA(0, 1), a2 + hstep, voffA);
            G_WAIT_L(8); G_BAR; G_WAIT_L(0); G_MMA(0, 0, At, B0); G_BAR; G_SCHED;
            G_LDB(B1, 1, 1); G_STAGE(G_SB(1, 0), b3, voffB);
            G_BAR; G_WAIT_L(0); G_MMA(0, 1, At, B1); G_BAR;
            G_LDA(At, 1, 1); G_STAGE(G_SA(1, 0), a3, voffA);
            G_BAR; G_WAIT_L(0); G_MMA(1, 0, At, B0); G_BAR; G_SCHED;
            G_STAGE(G_SB(1, 1), b3 + hstep, voffB);
            G_WAIT_V(6); G_BAR; G_MMA(1, 1, At, B1); G_BAR;
        }
        E(acc, cur, wr, wc, fr, fq);
        if (!has_next) break;
#pragma unroll
        for (int a = 0; a < 2; ++a)
#pragma unroll
            for (int b = 0; b < 2; ++b)
#pragma unroll
                for (int m = 0; m < 4; ++m)
#pragma unroll
                    for (int n = 0; n < 2; ++n) acc[a][b][m][n] = (f32x4){0.f, 0.f, 0.f, 0.f};
        cur = nxt; cA = nA; cB = nB; ++ui;
    }
    G_WAIT_V(0);
    if (wr == 0) G_BAR;
    G_BAR;
#undef G_SA
#undef G_SB
#undef G_STAGE
#undef G_LDA
#undef G_LDB
#undef G_MMA
#undef G_WAIT_V
#undef G_WAIT_L
#undef G_BAR
#undef G_SCHED
}

__device__ __forceinline__ u32x4 pack8(const f32x4& v0, const f32x4& v1) {
    u32x4 r; r[0] = pk2(v0[0], v0[1]); r[1] = pk2(v0[2], v0[3]); r[2] = pk2(v1[0], v1[1]); r[3] = pk2(v1[2], v1[3]); return r;
}

struct SchedP2 {
    const char* H; const char* W; int G, c;
    __device__ bool next(int i, GUnit& u) const {
        const int L = i * G + c; if (L >= 136 * 16) return false;
        tile_of(L, 136, 16, u.pm, u.pn);
        u.A = H + (size_t)u.pm * 256 * LDK * 2; u.B = W + (size_t)u.pn * 256 * LDK * 2; u.nt = 16; u.kind = 0; return true;
    }
};
struct EpiP2 {
    bf16_t* ulru; bf16_t* aa; bf16_t* ufft; bf16_t* abc; bf16_t* upool;
    __device__ __forceinline__ void operator()(const f32x4 (&acc)[2][2][4][2], const GUnit& u, int wr, int wc, int fr, int fq) const {
        const int pn = u.pn; bf16_t* base; int ldc, colb; bool act;
        if (pn < 4) { base = ulru; ldc = 1024; colb = pn * 256; act = false; }
        else if (pn < 8) { base = aa; ldc = 1024; colb = (pn - 4) * 256; act = true; }
        else if (pn < 10) { base = ufft; ldc = 512; colb = (pn - 8) * 256; act = false; }
        else if (pn < 12) { base = abc; ldc = 1024; colb = (pn - 10) * 256; act = true; }
        else if (pn < 14) { base = upool; ldc = 512; colb = (pn - 12) * 256; act = false; }
        else { base = abc; ldc = 1024; colb = 512 + (pn - 14) * 256; act = true; }
        const int row0 = u.pm * 256 + wr * 64 + fr, col0 = colb + wc * 32 + 8 * fq;
#pragma unroll
        for (int ai = 0; ai < 2; ++ai)
#pragma unroll
            for (int m = 0; m < 4; ++m) {
                bf16_t* rowp = base + (size_t)(row0 + ai * 128 + m * 16) * ldc + col0;
#pragma unroll
                for (int bj = 0; bj < 2; ++bj) {
                    f32x4 v0 = acc[ai][bj][m][0], v1 = acc[ai][bj][m][1];
                    if (act) {
#pragma unroll
                        for (int j = 0; j < 4; ++j) { v0[j] = silu(v0[j]); v1[j] = silu(v1[j]); }
                    }
                    __builtin_nontemporal_store(pack8(v0, v1), (u32x4*)(rowp + bj * 128));
                }
            }
    }
};

struct SchedMerge {
    const char* H; const char* AA; const char* ABC; const char* WG; const char* PA; const char* PBC; int G, c, mode;
    __device__ bool next(int i, GUnit& u) const {
        const int task = i / 6, sub = i - task * 6;
        if (mode == 1) { const int L = task * G + c; if (L >= 512) return false; tile_of(L, 128, 4, u.pm, u.pn); }
        else if (mode == 2) { if (c >= 32 || task > 0) return false; u.pm = 128 + (c >> 2); u.pn = c & 3; }
        else return false;
        const size_t ao = (size_t)u.pm * 256 * LDK * 2, bo = (size_t)u.pn * 256 * LDK * 2;
        u.kind = sub;
        if ((sub & 1) == 0) { u.A = H + ao; u.B = WG + (size_t)(sub >> 1) * 1024 * LDK * 2 + bo; u.nt = 16; }
        else if (sub == 1) { u.A = AA + ao; u.B = PA + bo; u.nt = 16; }
        else if (sub == 3) { u.A = ABC + ao; u.B = PBC + bo; u.nt = 8; }
        else { u.A = ABC + ao + 1024; u.B = PBC + bo + 1024; u.nt = 8; }
        return true;
    }
};
struct EpiMerge {
    u32x4* gs;
    bf16_t* m;
    __device__ __forceinline__ void operator()(const f32x4 (&acc)[2][2][4][2], const GUnit& u, int wr, int wc, int fr, int fq) const {
        const int kind = u.kind; const int tid = threadIdx.x;
        const int row0 = u.pm * 256 + wr * 64 + fr, col0 = u.pn * 256 + wc * 32 + 8 * fq;
        if ((kind & 1) == 0) {
#pragma unroll
            for (int ai = 0; ai < 2; ++ai)
#pragma unroll
                for (int mm = 0; mm < 4; ++mm) {
                    u32x4 w = (u32x4){0u, 0u, 0u, 0u};
#pragma unroll
                    for (int bj = 0; bj < 2; ++bj)
#pragma unroll
                        for (int n = 0; n < 2; ++n)
#pragma unroll
                            for (int j = 0; j < 4; ++j)
                                w[bj * 2 + n] = __builtin_amdgcn_cvt_pk_u8_f32(sigm(acc[ai][bj][mm][n][j]) * 255.f, j, w[bj * 2 + n]);
                    gs[(ai * 4 + mm) * 512 + tid] = w;
                }
        } else {
            const bool addold = (kind != 1);
#pragma unroll
            for (int am = 0; am < 4; ++am) {
                const int ai = am >> 1, mb = (am & 1) * 2;
                u32x4 gq[2], ov[4];
#pragma unroll
                for (int mi = 0; mi < 2; ++mi)
#pragma unroll
                    for (int bj = 0; bj < 2; ++bj) { const int mm = mb + mi;
                        if (bj == 0) gq[mi] = gs[(ai * 4 + mm) * 512 + tid];
                        ov[mi * 2 + bj] = (u32x4){0u, 0u, 0u, 0u};
                    }
                if (addold) {
#pragma unroll
                    for (int mi = 0; mi < 2; ++mi)
#pragma unroll
                        for (int bj = 0; bj < 2; ++bj) { const int mm = mb + mi;
                            ov[mi * 2 + bj] = *(const u32x4*)(m + (size_t)(row0 + ai * 128 + mm * 16) * 1024 + col0 + bj * 128); }
                }
#pragma unroll
                for (int mi = 0; mi < 2; ++mi)
#pragma unroll
                    for (int bj = 0; bj < 2; ++bj) { const int mm = mb + mi;
                        const unsigned g0w = gq[mi][bj * 2], g1w = gq[mi][bj * 2 + 1]; u32x4 o = ov[mi * 2 + bj];
                        if (!addold) o = (u32x4){0u, 0u, 0u, 0u};
                        const f32x4 v0 = acc[ai][bj][mm][0] * (1.f / 255.f), v1 = acc[ai][bj][mm][1] * (1.f / 255.f);
                        f32x4 r0, r1;
                        r0[0] = (float)(g0w & 255u) * v0[0] + bflo(o[0]); r0[1] = (float)((g0w >> 8) & 255u) * v0[1] + bfhi(o[0]); r0[2] = (float)((g0w >> 16) & 255u) * v0[2] + bflo(o[1]); r0[3] = (float)(g0w >> 24) * v0[3] + bfhi(o[1]);
                        r1[0] = (float)(g1w & 255u) * v1[0] + bflo(o[2]); r1[1] = (float)((g1w >> 8) & 255u) * v1[1] + bfhi(o[2]); r1[2] = (float)((g1w >> 16) & 255u) * v1[2] + bflo(o[3]); r1[3] = (float)(g1w >> 24) * v1[3] + bfhi(o[3]);
                        *(u32x4*)(m + (size_t)(row0 + ai * 128 + mm * 16) * 1024 + col0 + bj * 128) = pack8(r0, r1);
                    }
            }
        }
    }
};

struct SchedOut {
    const char* M; const char* W; int G, c, mode;
    __device__ bool next(int i, GUnit& u) const {
        if (mode == 1) { const int L = i * G + c; if (L >= 512) return false; tile_of(L, 128, 4, u.pm, u.pn); }
        else if (mode == 2) { if (c < 32) return false; const int L = i * (G - 32) + (c - 32); if (L >= 512) return false; tile_of(L, 128, 4, u.pm, u.pn); }
        else if (mode == 3) { if (c >= 32 || i > 0) return false; u.pm = 128 + (c >> 2); u.pn = c & 3; }
        else return false;
        u.A = M + (size_t)u.pm * 256 * LDK * 2; u.B = W + (size_t)u.pn * 256 * LDK * 2; u.nt = 16; u.kind = 0; return true;
    }
};
struct EpiOut {
    float* out; float* ctxres; const float* mod; float dryk;
    __device__ __forceinline__ void operator()(const f32x4 (&acc)[2][2][4][2], const GUnit& u, int wr, int wc, int fr, int fq) const {
        const int pm = u.pm; const bool lat = pm < 128; const int bb = lat ? (pm >> 4) : 8;
        float* base = lat ? out + (size_t)pm * 256 * 1024 : ctxres + (size_t)(pm - 128) * 256 * 1024;
        const float* gt = mod + bb * 3072 + 2048;
        const int r0 = wr * 64 + fr, col0 = u.pn * 256 + wc * 32 + 8 * fq;
#pragma unroll
        for (int bj = 0; bj < 2; ++bj) {
            const f32x4 g0 = *(const f32x4*)(gt + col0 + bj * 128) * dryk, g1 = *(const f32x4*)(gt + col0 + bj * 128 + 4) * dryk;
#pragma unroll
            for (int ai = 0; ai < 2; ++ai) {
                f32x4 o0[4], o1[4];
#pragma unroll
                for (int mm = 0; mm < 4; ++mm) { const float* rp = base + (size_t)(r0 + ai * 128 + mm * 16) * 1024 + col0 + bj * 128;
                    o0[mm] = *(const f32x4*)rp; o1[mm] = *(const f32x4*)(rp + 4); }
#pragma unroll
                for (int mm = 0; mm < 4; ++mm) { float* rp = base + (size_t)(r0 + ai * 128 + mm * 16) * 1024 + col0 + bj * 128;
                    *(f32x4*)rp = o0[mm] + g0 * acc[ai][bj][mm][0]; *(f32x4*)(rp + 4) = o1[mm] + g1 * acc[ai][bj][mm][1]; }
            }
        }
    }
};

__device__ void transpose_tile(const float* src, int ld_src, bf16_t* dst, int ld_dst, float* sT) {
    const int tid = tid_op(); const int nn = tid & 63, kk = tid >> 6;
#pragma unroll
    for (int i = 0; i < 8; ++i) { const int k = kk + 8 * i; sT[k * 65 + nn] = src[(size_t)k * ld_src + nn]; }
    __syncthreads();
    const int n = tid >> 3, k8 = tid & 7;
    u32x4 v;
#pragma unroll
    for (int j = 0; j < 4; ++j) v[j] = pk2(sT[(k8 * 8 + 2 * j) * 65 + n], sT[(k8 * 8 + 2 * j + 1) * 65 + n]);
    *(u32x4*)(dst + (size_t)n * ld_dst + k8 * 8) = v;
    __syncthreads();
}

__device__ void transpose_tile256(const float* src, int ld_src, bf16_t* dst, int ld_dst, float* sT) {
    const int tid = tid_op(); const int c4 = tid & 63, kk = tid >> 6;
    f32x4 v[8];
#pragma unroll
    for (int i = 0; i < 8; ++i) v[i] = *(const f32x4*)(src + (size_t)(kk + 8 * i) * ld_src + c4 * 4);
#pragma unroll
    for (int i = 0; i < 8; ++i) { float* d = sT + (kk + 8 * i) * 257 + c4 * 4; d[0] = v[i][0]; d[1] = v[i][1]; d[2] = v[i][2]; d[3] = v[i][3]; }
    __syncthreads();
#pragma unroll
    for (int i = 0; i < 4; ++i) { const int ch = tid + 512 * i, n = ch >> 3, k8 = ch & 7;
        u32x4 o;
#pragma unroll
        for (int j = 0; j < 4; ++j) o[j] = pk2(sT[(k8 * 8 + 2 * j) * 257 + n], sT[(k8 * 8 + 2 * j + 1) * 257 + n]);
        *(u32x4*)(dst + (size_t)n * ld_dst + k8 * 8) = o; }
    __syncthreads();
}

__device__ void phase0(const Params& p, unsigned char* smem) {
    unsigned char* ws = ptr_op(p.ws); const int tid = tid_op(); const int G = grd_op(), bid = bid_op();
    float* sT = (float*)smem;
    constexpr int B_WIN = 16 * 28, B_PA = 64, B_PB = 32, B_PC = 32, B_WO = 64, B_PER_L = B_WIN + B_PA + B_PB + B_PC + B_WO;
    for (int t = bid; t < 2 * B_PER_L; t += G) {
        const float* src; bf16_t* dst; int lds_;
        const int l = t / B_PER_L; int r = t - l * B_PER_L;
        if (r < B_WIN) { const int kt = r / 28, ntl = r % 28; src = p.w_in + (size_t)l * 1024 * INC + (size_t)kt * 64 * INC + ntl * 256; lds_ = INC;
            dst = (bf16_t*)(ws + WS_WINT) + (size_t)l * INC * 1024 + (size_t)ntl * 256 * 1024 + kt * 64; }
        else if ((r -= B_WIN) < B_PA) { const int kt = r / 4, ntl = r % 4; src = p.proj_a + (size_t)l * 1024 * 1024 + (size_t)kt * 64 * 1024 + ntl * 256; lds_ = 1024;
            dst = (bf16_t*)(ws + WS_PAT) + (size_t)l * 1024 * 1024 + (size_t)ntl * 256 * 1024 + kt * 64; }
        else if ((r -= B_PA) < B_PB) { const int kt = r / 4, ntl = r % 4; src = p.proj_b + (size_t)l * 512 * 1024 + (size_t)kt * 64 * 1024 + ntl * 256; lds_ = 1024;
            dst = (bf16_t*)(ws + WS_PBCT) + (size_t)l * 1024 * 1024 + (size_t)ntl * 256 * 1024 + kt * 64; }
        else if ((r -= B_PB) < B_PC) { const int kt = r / 4, ntl = r % 4; src = p.proj_c + (size_t)l * 512 * 1024 + (size_t)kt * 64 * 1024 + ntl * 256; lds_ = 1024;
            dst = (bf16_t*)(ws + WS_PBCT) + (size_t)l * 1024 * 1024 + (size_t)ntl * 256 * 1024 + 512 + kt * 64; }
        else { r -= B_PC; const int kt = r / 4, ntl = r % 4; src = p.w_out + (size_t)l * 1024 * 1024 + (size_t)kt * 64 * 1024 + ntl * 256; lds_ = 1024;
            dst = (bf16_t*)(ws + WS_WOT) + (size_t)l * 1024 * 1024 + (size_t)ntl * 256 * 1024 + kt * 64; }
        transpose_tile256(src, lds_, dst, 1024, sT);
    }
    constexpr int T_GATE = 128, T_POOL = 32;
    for (int t = bid; t < T_GATE + T_POOL; t += G) {
        const float* src; bf16_t* dst; int lds_, ldd; int r = t;
        if (r < T_GATE) { const int head = r & 15, gx = (r >> 4) & 1, dir = (r >> 5) & 1, l = r >> 6;
            src = (gx ? p.lru_wx : p.lru_wa) + ((size_t)((l * 2 + dir) * 16 + head)) * 4096; lds_ = 64;
            dst = (bf16_t*)(ws + WS_GATE) + ((size_t)(l * 16 + head) * 256 + (2 * dir + gx) * 64) * 64; ldd = 64; }
        else { r -= T_GATE; const int sub = r & 3, lg = r >> 2; const int kt = sub >> 1, ntl = sub & 1;
            src = p.pool_w + (size_t)lg * 128 * 128 + (size_t)kt * 64 * 128 + ntl * 64; lds_ = 128;
            dst = (bf16_t*)(ws + WS_POOLT) + (size_t)lg * 128 * 128 + (size_t)ntl * 64 * 128 + kt * 64; ldd = 128; }
        transpose_tile(src, lds_, dst, ldd, sT);
    }
    float* sTab = (float*)smem;
    __syncthreads();
    if (tid < 128) { sTab[tid] = __builtin_amdgcn_cosf((float)tid * (1.f / 128.f)); sTab[128 + tid] = __builtin_amdgcn_sinf((float)tid * (1.f / 128.f)); }
    __syncthreads();
    for (int idx = bid * 512 + tid; idx < 2 * 4 * 128 * 256; idx += G * 512) {
        const int k = idx & 255, n = (idx >> 8) & 127, lg = idx >> 15;
        const float* W = p.fft_w + (size_t)lg * 128 * 128 + n;
        const int kk = k & 127; const float* tab = sTab + (k >> 7) * 128;
        float s = 0.f;
        for (int m0 = 0; m0 < 128; m0 += 16) {
            float wv[16];
#pragma unroll
            for (int m = 0; m < 16; ++m) wv[m] = W[(m0 + m) * 128];
#pragma unroll
            for (int m = 0; m < 16; ++m) s += tab[(kk * (m0 + m)) & 127] * wv[m];
        }
        ((bf16_t*)(ws + WS_CWSW))[idx] = f2bf(s * 0.08838834764831845f);
    }
    for (int idx = bid * 512 + tid; idx < 128 * 64; idx += G * 512) {
        const int m = idx >> 6, k = idx & 63; const float rv = (float)(((m & 63) * k) & 63) * (1.f / 64.f); const float s = __builtin_amdgcn_sinf(rv), c = __builtin_amdgcn_cosf(rv);
        ((bf16_t*)(ws + WS_F1))[idx] = f2bf((m < 64 ? c : -s) * 0.125f);
    }
    for (int idx = bid * 512 + tid; idx < 128 * 128; idx += G * 512) {
        const int m = idx >> 7, k = idx & 127; const float rv = (float)(((m & 63) * (k & 63)) & 63) * (1.f / 64.f); const float s = __builtin_amdgcn_sinf(rv), c = __builtin_amdgcn_cosf(rv);
        float v; if (m < 64) v = (k < 64) ? c : s; else v = (k < 64) ? -s : c;
        ((bf16_t*)(ws + WS_G2))[idx] = f2bf(v * 0.125f);
    }
    for (int idx = bid * 512 + tid; idx < 4096; idx += G * 512) {
        const float s = __builtin_amdgcn_sinf((float)idx * (1.f / 4096.f)), c = __builtin_amdgcn_cosf((float)idx * (1.f / 4096.f));
        ((float*)(ws + WS_TW))[idx * 2] = c; ((float*)(ws + WS_TW))[idx * 2 + 1] = s;
    }
    for (int idx = bid * 512 + tid; idx < 64 * 512; idx += G * 512) {
        const int pp = idx >> 9, cidx = idx & 511, i = cidx & 255;
        const float omega = __builtin_amdgcn_exp2f(-(float)i * (13.287712379549449f / 256.f));
        const float rv = (float)pp * omega * 0.15915494309189535f;
        const float fr = rv - floorf(rv);
        ((float*)(ws + WS_POS))[idx] = (cidx < 256) ? __builtin_amdgcn_sinf(fr) : __builtin_amdgcn_cosf(fr);
    }
    for (int idx = bid * 512 + tid; idx < 2 * 2 * 1024; idx += G * 512) { const float e = __expf(-p.lru_lam[idx]); ((float*)(ws + WS_SP))[idx] = (e < 0.05f) ? e * (1.f + e * (-0.5f + e * ((1.f / 3.f) + e * (-0.25f + e * 0.2f)))) : __logf(1.f + e); }
    float* sS = (float*)smem;
    float* sR = sS + 9 * 1024;
    __syncthreads();
    for (int i = tid; i < 9 * 1024; i += 512) { const int bb = i >> 10, k = i & 1023; const float v = (bb < 8) ? p.c[bb * 1024 + k] : p.c_ctx[k]; sS[i] = silu(v); }
    __syncthreads();
    for (int t = bid; t < 96; t += G) {
        const int l = t / 48, n0 = (t % 48) * 64; const int nn = tid & 63, ks = tid >> 6;
        float a[9];
#pragma unroll
        for (int b = 0; b < 9; ++b) a[b] = 0.f;
        const float* W = p.ada_w + (size_t)l * 1024 * 3072 + n0 + nn;
        for (int k0 = ks * 128; k0 < ks * 128 + 128; k0 += 16) {
            float wv[16];
#pragma unroll
            for (int kk = 0; kk < 16; ++kk) wv[kk] = W[(size_t)(k0 + kk) * 3072];
#pragma unroll
            for (int kk = 0; kk < 16; ++kk)
#pragma unroll
                for (int b = 0; b < 9; ++b) a[b] += sS[b * 1024 + k0 + kk] * wv[kk];
        }
#pragma unroll
        for (int b = 0; b < 9; ++b) sR[(ks * 9 + b) * 64 + nn] = a[b];
        __syncthreads();
        for (int i = tid; i < 9 * 64; i += 512) { const int b = i >> 6, n = i & 63; float s = p.ada_b[l * 3072 + n0 + n];
#pragma unroll
            for (int k8 = 0; k8 < 8; ++k8) s += sR[(k8 * 9 + b) * 64 + n];
            ((float*)(ws + WS_MOD))[(size_t)(l * 9 + b) * 3072 + n0 + n] = s; }
        __syncthreads();
    }
}

__device__ void phase_norm(const Params& p, int l) {
    unsigned char* ws = ptr_op(p.ws); const int tid_ = tid_op(); const int lane = tid_ & 63, wid = tid_ >> 6;
    const float* mod = (const float*)(ws + WS_MOD) + (size_t)l * 9 * 3072;
    const float* g = p.norm_g + l * 1024; const float* pos = (const float*)(ws + WS_POS);
    bf16_t* H = (bf16_t*)(ws + WS_H); float* ctxres = (float*)(ws + WS_CTXRES);
    constexpr int NR = 4;
    for (int r0 = (bid_op() * 8 + wid) * NR; r0 < NT; r0 += grd_op() * 8 * NR) {
        const bool lat = r0 < NLAT; const int bb = lat ? (r0 >> 12) : 8;
        float* res = lat ? p.out + (size_t)r0 * 1024 : ctxres + (size_t)(r0 - NLAT) * 1024;
        f32x4 v[NR][4];
        if (l == 0) {
            const float* src = lat ? p.x + (size_t)r0 * 1024 : p.ctx + (size_t)(r0 - NLAT) * 1024;
#pragma unroll
            for (int rr = 0; rr < NR; ++rr)
#pragma unroll
                for (int i = 0; i < 4; ++i) v[rr][i] = *(const f32x4*)(src + rr * 1024 + i * 256 + lane * 4);
            if (lat) {
#pragma unroll
                for (int rr = 0; rr < NR; ++rr) { const int t = (r0 + rr) & 4095, gr = t >> 6, gc = t & 63;
#pragma unroll
                    for (int i = 0; i < 4; ++i) { const int col = i * 256 + lane * 4; const int pp = (col < 512) ? gr : gc; v[rr][i] += *(const f32x4*)(pos + pp * 512 + (col & 511)); } }
            }
#pragma unroll
            for (int rr = 0; rr < NR; ++rr)
#pragma unroll
                for (int i = 0; i < 4; ++i) __builtin_nontemporal_store(v[rr][i], (f32x4*)(res + rr * 1024 + i * 256 + lane * 4));
        } else {
#pragma unroll
            for (int rr = 0; rr < NR; ++rr)
#pragma unroll
                for (int i = 0; i < 4; ++i) v[rr][i] = *(const f32x4*)(res + rr * 1024 + i * 256 + lane * 4);
        }
        float rstd[NR];
#pragma unroll
        for (int rr = 0; rr < NR; ++rr) { float ss = 0.f;
#pragma unroll
            for (int i = 0; i < 4; ++i) ss += v[rr][i][0] * v[rr][i][0] + v[rr][i][1] * v[rr][i][1] + v[rr][i][2] * v[rr][i][2] + v[rr][i][3] * v[rr][i][3];
            ss = wave_sum(ss); rstd[rr] = rsqrtf(ss * (1.f / 1024.f) + 1e-6f); }
        const float* sh = mod + bb * 3072; const float* sc = sh + 1024;
#pragma unroll
        for (int i = 0; i < 4; ++i) { const int col = i * 256 + lane * 4;
            const f32x4 gg = *(const f32x4*)(g + col), s1 = *(const f32x4*)(sc + col) + 1.f, s0 = *(const f32x4*)(sh + col);
#pragma unroll
            for (int rr = 0; rr < NR; ++rr) {
                f32x4 y = (v[rr][i] * rstd[rr]) * gg; y = y * s1 + s0;
                u32x2 o; o[0] = pk2(y[0], y[1]); o[1] = pk2(y[2], y[3]);
                *(u32x2*)(H + (size_t)(r0 + rr) * 1024 + col) = o; } }
    }
}

__device__ void phase_final(const Params& p) {
    const int tid_ = tid_op(); const int lane = tid_ & 63, wid = tid_ >> 6;
    constexpr int NR = 4;
    const int stride = grd_op() * 8 * NR;
    f32x4 v[NR][4], vn[NR][4], gg[4];
#pragma unroll
    for (int i = 0; i < 4; ++i) gg[i] = *(const f32x4*)(p.final_g + i * 256 + lane * 4);
    int r0 = (bid_op() * 8 + wid) * NR;
    if (r0 < NLAT) {
#pragma unroll
        for (int rr = 0; rr < NR; ++rr)
#pragma unroll
            for (int i = 0; i < 4; ++i) v[rr][i] = *(const f32x4*)(p.out + (size_t)(r0 + rr) * 1024 + i * 256 + lane * 4); }
    while (r0 < NLAT) {
        const int rn = r0 + stride;
        if (rn < NLAT) {
#pragma unroll
            for (int rr = 0; rr < NR; ++rr)
#pragma unroll
                for (int i = 0; i < 4; ++i) vn[rr][i] = *(const f32x4*)(p.out + (size_t)(rn + rr) * 1024 + i * 256 + lane * 4); }
        float* res = p.out + (size_t)r0 * 1024;
        float rstd[NR];
#pragma unroll
        for (int rr = 0; rr < NR; ++rr) { float ss = 0.f;
#pragma unroll
            for (int i = 0; i < 4; ++i) ss += v[rr][i][0] * v[rr][i][0] + v[rr][i][1] * v[rr][i][1] + v[rr][i][2] * v[rr][i][2] + v[rr][i][3] * v[rr][i][3];
            ss = wave_sum(ss); rstd[rr] = rsqrtf(ss * (1.f / 1024.f) + 1e-6f); }
#pragma unroll
        for (int i = 0; i < 4; ++i) { const int col = i * 256 + lane * 4;
#pragma unroll
            for (int rr = 0; rr < NR; ++rr) __builtin_nontemporal_store((v[rr][i] * rstd[rr]) * gg[i], (f32x4*)(res + rr * 1024 + col)); }
#pragma unroll
        for (int rr = 0; rr < NR; ++rr)
#pragma unroll
            for (int i = 0; i < 4; ++i) v[rr][i] = vn[rr][i];
        r0 = rn;
    }
}

constexpr int LRU_SW = 0;
constexpr int LRU_SXB = 36864;
constexpr int LRU_SXF = LRU_SXB + 9216;
constexpr int LRU_SHF = LRU_SXF + 17408;
constexpr int LRU_SHB = LRU_SHF + 17408;

template <bool REV>
__device__ __forceinline__ void tile_scan(const float (&a)[4], const float (&b)[4], float (&h)[4], float& carry, float& atot, int c16) {
    float P[4], hl[4];
    if (!REV) { P[0] = a[0]; hl[0] = b[0];
#pragma unroll
        for (int j = 1; j < 4; ++j) { P[j] = a[j] * P[j - 1]; hl[j] = a[j] * hl[j - 1] + b[j]; } }
    else { P[3] = a[3]; hl[3] = b[3];
#pragma unroll
        for (int j = 2; j >= 0; --j) { P[j] = a[j] * P[j + 1]; hl[j] = a[j] * hl[j + 1] + b[j]; } }
    const float A4 = REV ? P[0] : P[3], H4 = REV ? hl[0] : hl[3];
    float Aq[4], Hq[4];
#pragma unroll
    for (int qq = 0; qq < 4; ++qq) { Aq[qq] = __shfl(A4, c16 + 16 * qq, 64); Hq[qq] = __shfl(H4, c16 + 16 * qq, 64); }
    const int q = (__lane_id()) >> 4;
    float S = carry, mine = carry;
#pragma unroll
    for (int s = 0; s < 4; ++s) { const int qq = REV ? 3 - s : s; if (q == qq) mine = S; S = Aq[qq] * S + Hq[qq]; atot *= Aq[qq]; }
    carry = S;
#pragma unroll
    for (int j = 0; j < 4; ++j) h[j] = hl[j] + P[j] * mine;
}

template <int PASS, bool REV>
__device__ __forceinline__ void lru_wave(const f32x4 (&acca)[4], const f32x4 (&accx)[4], const float* sXf, float* sHd, int ntile, int c16, int q,
                                         float nba, float nbx, float c8, float cin, float& aggA, float& aggH) {
    float carry = (PASS == 2) ? cin : 0.f, atot = 1.f;
#pragma unroll
    for (int s = 0; s < 4; ++s) {
        const int mt = REV ? 3 - s : s;
        float a[4], b[4], h[4];
#pragma unroll
        for (int j = 0; j < 4; ++j) {
            const int t = mt * 16 + 4 * q + j;
            const float xc = sXf[t * 68 + ntile * 16 + c16];
            const float r = __builtin_amdgcn_rcpf(1.f + __builtin_amdgcn_exp2f(fmaf(acca[mt][j], -1.4426950408889634f, nba)));
            const float ig = __builtin_amdgcn_rcpf(1.f + __builtin_amdgcn_exp2f(fmaf(accx[mt][j], -1.4426950408889634f, nbx)));
            const float x = c8 * r;
            float xq = x * (1.f + x * (-0.5f + x * ((1.f / 6.f) + x * ((-1.f / 24.f) + x * ((1.f / 120.f) + x * ((-1.f / 720.f) + x * (1.f / 5040.f)))))));
            if (x >= 0.25f) xq = 1.f - __expf(-x);
            a[j] = 1.f - xq;
            b[j] = __builtin_amdgcn_sqrtf(xq * (2.f - xq)) * (ig * xc);
        }
        tile_scan<REV>(a, b, h, carry, atot, c16);
        if (PASS == 2) {
#pragma unroll
            for (int j = 0; j < 4; ++j) sHd[(mt * 16 + 4 * q + j) * 68 + ntile * 16 + c16] = h[j];
        }
    }
    aggA = atot; aggH = carry;
}

constexpr int LRU_SCIN = LRU_SHB + 17408;

template <int PASS>
__device__ void phase_lru(const Params& p, int l, unsigned char* smem, bool dry = false) {
    unsigned char* ws = ptr_op(p.ws); const int tid = tid_op(), lane = tid & 63, wid = tid >> 6, c16 = lane & 15, q = lane >> 4;
    const int G = grd_op(); constexpr int NTASK = 16 * 8 * NCH;
    const int per = (NTASK + G - 1) / G; const int t_lo = bid_op() * per, t_hi = (t_lo + per < NTASK) ? t_lo + per : NTASK;
    bf16_t* sW = (bf16_t*)(smem + LRU_SW); bf16_t* sXb = (bf16_t*)(smem + LRU_SXB); float* sXf = (float*)(smem + LRU_SXF);
    float* sHf = (float*)(smem + LRU_SHF); float* sHb = (float*)(smem + LRU_SHB); float* sCin = (float*)(smem + LRU_SCIN);
    const bf16_t* ULRU = (const bf16_t*)(ws + WS_ULRU); bf16_t* AA = (bf16_t*)(ws + WS_AA);
    float* AGGA = (float*)(ws + WS_AGGA); float* AGGH = (float*)(ws + WS_AGGH);
    const float* SP = (const float*)(ws + WS_SP);
    const bool skipctx = (PASS == 2 && l == 1);
    const int d = wid >> 2, ntile = wid & 3;
    const int cc = tid & 63, tb = tid >> 6;
    int cur_head = -1, cur_hb = -1;
    float w0 = 0.f, w1 = 0.f, w2 = 0.f, w3 = 0.f, cb = 0.f, nba = 0.f, nbx = 0.f, c8 = 0.f;
    unsigned short uraw[11];
    auto first_valid = [&](int t) { if (skipctx && t < t_hi) { const int ch = t % NCH; if (ch < 4) t += 4 - ch; } return t; };
    auto load_u = [&](int task) {
        const int chunk = task % NCH, hb = task / NCH, b = hb & 7, head = hb >> 3;
        int rowbase, t0, seqlen;
        if (chunk < 4) { rowbase = NLAT + b * TCX; t0 = chunk * 64; seqlen = TCX; } else { rowbase = b * TL; t0 = (chunk - 4) * 64; seqlen = TL; }
#pragma unroll
        for (int i = 0; i < 11; ++i) { int tt = t0 + tb * 8 + i - 2; tt = tt < 0 ? 0 : (tt >= seqlen ? seqlen - 1 : tt);
            uraw[i] = ULRU[(size_t)(rowbase + tt) * 1024 + head * 64 + cc]; }
    };
    int task = first_valid(t_lo);
    if (task < t_hi) load_u(task);
    while (task < t_hi) {
        const int chunk = task % NCH, hb = task / NCH, b = hb & 7, head = hb >> 3;
        int rowbase, t0, seqlen_c;
        if (chunk < 4) { rowbase = NLAT + b * TCX; t0 = chunk * 64; seqlen_c = TCX; } else { rowbase = b * TL; t0 = (chunk - 4) * 64; seqlen_c = TL; }
        if (head != cur_head) {
            const bf16_t* Wg = (const bf16_t*)(ws + WS_GATE) + (size_t)(l * 16 + head) * 256 * 64;
#pragma unroll
            for (int i = 0; i < 4; ++i) { const int ch = tid + 512 * i, row = ch >> 3, c8i = ch & 7;
                *(u32x4*)(sW + row * 72 + c8i * 8) = *(const u32x4*)(Wg + row * 64 + c8i * 8); }
            const float* cw = p.conv_w + (size_t)l * 4 * 1024 + head * 64 + cc;
            w0 = cw[0]; w1 = cw[1024]; w2 = cw[2048]; w3 = cw[3072]; cb = p.conv_b[l * 1024 + head * 64 + cc];
            const int chg = (l * 2 + d) * 1024 + head * 64 + ntile * 16 + c16;
            nba = -1.4426950408889634f * p.lru_ba[chg]; nbx = -1.4426950408889634f * p.lru_bx[chg]; c8 = 8.f * SP[chg];
            cur_head = head;
        }
        if (PASS == 2 && hb != cur_hb) {
            if (tid < 128) {
                const int ch = tid & 63, dd = tid >> 6;
                const size_t base = (size_t)(b * 2 + dd) * NCH * 1024 + head * 64 + ch;
                float av[NCH], hv[NCH];
#pragma unroll
                for (int k = 0; k < NCH; ++k) { av[k] = AGGA[base + (size_t)k * 1024]; hv[k] = AGGH[base + (size_t)k * 1024]; }
                float s = 0.f; float* sc = sCin + dd * NCH * 64 + ch;
                if (dd == 0) {
#pragma unroll
                    for (int k = 0; k < NCH; ++k) { sc[k * 64] = s; s = av[k] * s + hv[k]; }
                } else {
#pragma unroll
                    for (int k = 3; k >= 0; --k) { sc[k * 64] = s; s = av[k] * s + hv[k]; }
#pragma unroll
                    for (int k = NCH - 1; k >= 4; --k) { sc[k * 64] = s; s = av[k] * s + hv[k]; }
                }
            }
            cur_hb = hb;
        }
        u32x4 szraw = (u32x4){0u, 0u, 0u, 0u};
        bf16_t* aap = AA + (size_t)(rowbase + t0 + (tid >> 3)) * 1024 + head * 64 + (tid & 7) * 8;
        if (PASS == 2) szraw = *(const u32x4*)aap;
        float uu[11];
#pragma unroll
        for (int i = 0; i < 11; ++i) { const int tt = t0 + tb * 8 + i - 2; uu[i] = (tt >= 0 && tt < seqlen_c) ? bf2f(uraw[i]) : 0.f; }
#pragma unroll
        for (int i = 0; i < 8; ++i) { const float xc = cb + w0 * uu[i] + w1 * uu[i + 1] + w2 * uu[i + 2] + w3 * uu[i + 3];
            const int t = tb * 8 + i; sXf[t * 68 + cc] = xc; sXb[t * 72 + cc] = f2bf(xc); }
        const int nxt = first_valid(task + 1);
        if (nxt < t_hi) load_u(nxt);
        lds_barrier();
        {
            f32x4 acca[4], accx[4];
#pragma unroll
            for (int mt = 0; mt < 4; ++mt) { acca[mt] = (f32x4){0.f, 0.f, 0.f, 0.f}; accx[mt] = (f32x4){0.f, 0.f, 0.f, 0.f}; }
            const int na = (2 * d) * 64 + ntile * 16, nx = (2 * d + 1) * 64 + ntile * 16;
#pragma unroll
            for (int ks = 0; ks < 2; ++ks) {
                const bf16x8 fa = *(const bf16x8*)(sW + (na + c16) * 72 + ks * 32 + q * 8);
                const bf16x8 fx = *(const bf16x8*)(sW + (nx + c16) * 72 + ks * 32 + q * 8);
#pragma unroll
                for (int mt = 0; mt < 4; ++mt) {
                    const bf16x8 xa = *(const bf16x8*)(sXb + (mt * 16 + c16) * 72 + ks * 32 + q * 8);
                    acca[mt] = __builtin_amdgcn_mfma_f32_16x16x32_bf16(xa, fa, acca[mt], 0, 0, 0);
                    accx[mt] = __builtin_amdgcn_mfma_f32_16x16x32_bf16(xa, fx, accx[mt], 0, 0, 0);
                }
            }
            const float cin = (PASS == 2) ? sCin[(d * NCH + chunk) * 64 + ntile * 16 + c16] : 0.f;
            float aggA, aggH;
            if (d == 0) lru_wave<PASS, false>(acca, accx, sXf, sHf, ntile, c16, q, nba, nbx, c8, cin, aggA, aggH);
            else lru_wave<PASS, true>(acca, accx, sXf, sHb, ntile, c16, q, nba, nbx, c8, cin, aggA, aggH);
            if (PASS == 1 && q == 0) { const size_t cidx = ((size_t)(b * 2 + d) * NCH + chunk) * 1024 + head * 64 + ntile * 16 + c16; AGGA[cidx] = aggA; AGGH[cidx] = aggH; }
        }
        if (PASS == 2) {
            lds_barrier();
            { const int t = tid >> 3, c8 = (tid & 7) * 8;
              const f32x4 f0 = *(const f32x4*)(sHf + t * 68 + c8), f1 = *(const f32x4*)(sHf + t * 68 + c8 + 4);
              const f32x4 b0 = *(const f32x4*)(sHb + t * 68 + c8), b1 = *(const f32x4*)(sHb + t * 68 + c8 + 4);
              f32x4 y0 = f0 + b0, y1 = f1 + b1;
              y0[0] *= bflo(szraw[0]); y0[1] *= bfhi(szraw[0]); y0[2] *= bflo(szraw[1]); y0[3] *= bfhi(szraw[1]);
              y1[0] *= bflo(szraw[2]); y1[1] *= bfhi(szraw[2]); y1[2] *= bflo(szraw[3]); y1[3] *= bfhi(szraw[3]);
              *(u32x4*)aap = dry ? szraw : pack8(y0, y1); }
        }
        lds_barrier();
        task = nxt;
    }
}

constexpr int LP1_SXB = 36864;
constexpr int LP1_SXF = LP1_SXB + 18432;
__device__ void phase_lru_p1(const Params& p, int l, unsigned char* smem) {
    unsigned char* ws = ptr_op(p.ws); const int tid = tid_op(), lane = tid & 63, wid = tid >> 6, c16 = lane & 15, q = lane >> 4;
    const int G = grd_op(); constexpr int NPAIR = 16 * 8 * (NCH / 2);
    const int per = (NPAIR + G - 1) / G; const int p_lo = bid_op() * per, p_hi = (p_lo + per < NPAIR) ? p_lo + per : NPAIR;
    bf16_t* sW = (bf16_t*)(smem + LRU_SW); bf16_t* sXb = (bf16_t*)(smem + LP1_SXB); float* sXf = (float*)(smem + LP1_SXF);
    const bf16_t* ULRU = (const bf16_t*)(ws + WS_ULRU);
    float* AGGA = (float*)(ws + WS_AGGA); float* AGGH = (float*)(ws + WS_AGGH);
    const float* SP = (const float*)(ws + WS_SP);
    const int d = wid >> 2, ntile = wid & 3;
    const int cc = tid & 63, tb = tid >> 6;
    int cur_head = -1;
    float w0 = 0.f, w1 = 0.f, w2 = 0.f, w3 = 0.f, cb = 0.f, nba = 0.f, nbx = 0.f, c8 = 0.f;
    unsigned short uraw[19];
    auto load_u = [&](int pi) {
        const int pc = pi % (NCH / 2), hb = pi / (NCH / 2), b = hb & 7, head = hb >> 3, chunk = 2 * pc;
        int rowbase, t0, seqlen;
        if (chunk < 4) { rowbase = NLAT + b * TCX; t0 = chunk * 64; seqlen = TCX; } else { rowbase = b * TL; t0 = (chunk - 4) * 64; seqlen = TL; }
#pragma unroll
        for (int i = 0; i < 19; ++i) { int tt = t0 + tb * 16 + i - 2; tt = tt < 0 ? 0 : (tt >= seqlen ? seqlen - 1 : tt);
            uraw[i] = ULRU[(size_t)(rowbase + tt) * 1024 + head * 64 + cc]; }
    };
    int pi = p_lo;
    if (pi < p_hi) load_u(pi);
    while (pi < p_hi) {
        const int pc = pi % (NCH / 2), hb = pi / (NCH / 2), b = hb & 7, head = hb >> 3, chunk = 2 * pc;
        int t0, seqlen_c;
        if (chunk < 4) { t0 = chunk * 64; seqlen_c = TCX; } else { t0 = (chunk - 4) * 64; seqlen_c = TL; }
        if (head != cur_head) {
            const bf16_t* Wg = (const bf16_t*)(ws + WS_GATE) + (size_t)(l * 16 + head) * 256 * 64;
#pragma unroll
            for (int i = 0; i < 4; ++i) { const int ch = tid + 512 * i, row = ch >> 3, c8i = ch & 7;
                *(u32x4*)(sW + row * 72 + c8i * 8) = *(const u32x4*)(Wg + row * 64 + c8i * 8); }
            const float* cw = p.conv_w + (size_t)l * 4 * 1024 + head * 64 + cc;
            w0 = cw[0]; w1 = cw[1024]; w2 = cw[2048]; w3 = cw[3072]; cb = p.conv_b[l * 1024 + head * 64 + cc];
            const int chg = (l * 2 + d) * 1024 + head * 64 + ntile * 16 + c16;
            nba = -1.4426950408889634f * p.lru_ba[chg]; nbx = -1.4426950408889634f * p.lru_bx[chg]; c8 = 8.f * SP[chg];
            cur_head = head;
        }
        {
            float uu[19];
#pragma unroll
            for (int i = 0; i < 19; ++i) { const int tt = t0 + tb * 16 + i - 2; uu[i] = (tt >= 0 && tt < seqlen_c) ? bf2f(uraw[i]) : 0.f; }
#pragma unroll
            for (int i = 0; i < 16; ++i) { const float xc = cb + w0 * uu[i] + w1 * uu[i + 1] + w2 * uu[i + 2] + w3 * uu[i + 3];
                const int t = tb * 16 + i; sXf[t * 68 + cc] = xc; sXb[t * 72 + cc] = f2bf(xc); }
        }
        const int nxt = pi + 1;
        if (nxt < p_hi) load_u(nxt);
        lds_barrier();
        {
            f32x4 acca0[4], accx0[4], acca1[4], accx1[4];
#pragma unroll
            for (int mt = 0; mt < 4; ++mt) { acca0[mt] = (f32x4){0.f, 0.f, 0.f, 0.f}; accx0[mt] = (f32x4){0.f, 0.f, 0.f, 0.f}; acca1[mt] = (f32x4){0.f, 0.f, 0.f, 0.f}; accx1[mt] = (f32x4){0.f, 0.f, 0.f, 0.f}; }
            const int na = (2 * d) * 64 + ntile * 16, nx = (2 * d + 1) * 64 + ntile * 16;
#pragma unroll
            for (int ks = 0; ks < 2; ++ks) {
                const bf16x8 fa = *(const bf16x8*)(sW + (na + c16) * 72 + ks * 32 + q * 8);
                const bf16x8 fx = *(const bf16x8*)(sW + (nx + c16) * 72 + ks * 32 + q * 8);
#pragma unroll
                for (int mt = 0; mt < 4; ++mt) {
                    const bf16x8 xa = *(const bf16x8*)(sXb + (mt * 16 + c16) * 72 + ks * 32 + q * 8);
                    const bf16x8 xb = *(const bf16x8*)(sXb + (64 + mt * 16 + c16) * 72 + ks * 32 + q * 8);
                    acca0[mt] = __builtin_amdgcn_mfma_f32_16x16x32_bf16(xa, fa, acca0[mt], 0, 0, 0);
                    accx0[mt] = __builtin_amdgcn_mfma_f32_16x16x32_bf16(xa, fx, accx0[mt], 0, 0, 0);
                    acca1[mt] = __builtin_amdgcn_mfma_f32_16x16x32_bf16(xb, fa, acca1[mt], 0, 0, 0);
                    accx1[mt] = __builtin_amdgcn_mfma_f32_16x16x32_bf16(xb, fx, accx1[mt], 0, 0, 0);
                }
            }
            float aA0, aH0, aA1, aH1;
            if (d == 0) { lru_wave<1, false>(acca0, accx0, sXf, nullptr, ntile, c16, q, nba, nbx, c8, 0.f, aA0, aH0);
                          lru_wave<1, false>(acca1, accx1, sXf + 64 * 68, nullptr, ntile, c16, q, nba, nbx, c8, 0.f, aA1, aH1); }
            else        { lru_wave<1, true>(acca0, accx0, sXf, nullptr, ntile, c16, q, nba, nbx, c8, 0.f, aA0, aH0);
                          lru_wave<1, true>(acca1, accx1, sXf + 64 * 68, nullptr, ntile, c16, q, nba, nbx, c8, 0.f, aA1, aH1); }
            if (q == 0) { const size_t cidx = ((size_t)(b * 2 + d) * NCH + chunk) * 1024 + head * 64 + ntile * 16 + c16;
                AGGA[cidx] = aA0; AGGH[cidx] = aH0; AGGA[cidx + 1024] = aA1; AGGH[cidx + 1024] = aH1; }
        }
        lds_barrier();
        pi = nxt;
    }
}

typedef short s16x4 __attribute__((ext_vector_type(4)));
__device__ __forceinline__ bf16x8 tr_bfrag(const bf16_t* tile, int ld, int krow0, int c0, int c16) {
    const int qq = c16 >> 2, pp = c16 & 3;
    const bf16_t* a0 = tile + (krow0 + qq) * ld + c0 + 4 * pp;
    const s16x4 v0 = __builtin_amdgcn_ds_read_tr16_b64_v4i16((LAS s16x4*)a0);
    const s16x4 v1 = __builtin_amdgcn_ds_read_tr16_b64_v4i16((LAS s16x4*)(a0 + 4 * ld));
    bf16x8 r; r[0] = v0[0]; r[1] = v0[1]; r[2] = v0[2]; r[3] = v0[3]; r[4] = v1[0]; r[5] = v1[1]; r[6] = v1[2]; r[7] = v1[3];
    return r;
}

constexpr int F1_SF = 0;
constexpr int F1_SB = 18432;
constexpr int F1_SO = F1_SB + 33280;
constexpr int F1_TW = F1_SO + 67584;
__device__ void phase_fft1(const Params& p, unsigned char* smem) {
    unsigned char* ws = ptr_op(p.ws); const int tid = tid_op(), lane = tid & 63, wid = tid >> 6, c16 = lane & 15, q = lane >> 4;
    bf16_t* sF = (bf16_t*)(smem + F1_SF); bf16_t* sB = (bf16_t*)(smem + F1_SB); bf16_t* sO = (bf16_t*)(smem + F1_SO); float* sTW = (float*)(smem + F1_TW);
    const bf16_t* UF = (const bf16_t*)(ws + WS_UFFT); bf16_t* APR = (bf16_t*)(ws + WS_APR); const float* TW = (const float*)(ws + WS_TW);
    const bf16_t* F1 = (const bf16_t*)(ws + WS_F1);
    const int NTASK = NB * 64 * 2, G = grd_op();
#pragma unroll
    for (int i = 0; i < 2; ++i) { const int ch = tid + 512 * i, row = ch >> 3, c8 = ch & 7; *(u32x4*)(sF + row * 72 + c8 * 8) = *(const u32x4*)(F1 + row * 64 + c8 * 8); }
    u32x4 tile[4]; float twv = 0.f;
    auto load_tile = [&](int task) {
        const int jh = task & 1, t2 = (task >> 1) & 63, b = task >> 7;
#pragma unroll
        for (int i = 0; i < 4; ++i) { const int ch = tid + 512 * i, t1 = ch >> 5, cc = ch & 31;
            tile[i] = *(const u32x4*)(UF + ((size_t)(b * TL + 64 * t1 + t2)) * 512 + jh * 256 + cc * 8); }
        twv = TW[(((tid & 127) >> 1) * t2) * 2 + (tid & 1)];
    };
    int task = bid_op();
    if (task < NTASK) load_tile(task);
    while (task < NTASK) {
        const int jh = task & 1, t2 = (task >> 1) & 63, b = task >> 7;
        if (tid < 128) sTW[tid] = twv;
#pragma unroll
        for (int i = 0; i < 4; ++i) { const int ch = tid + 512 * i, t1 = ch >> 5, cc = ch & 31;
            u32x2* dp = (u32x2*)(sB + t1 * 260 + cc * 8); u32x2 lo, hi; lo[0] = tile[i][0]; lo[1] = tile[i][1]; hi[0] = tile[i][2]; hi[1] = tile[i][3]; dp[0] = lo; dp[1] = hi; }
        const int nxt = task + G;
        if (nxt < NTASK) load_tile(nxt);
        lds_barrier();
#pragma unroll
        for (int ntl = 0; ntl < 2; ++ntl) {
            const int nt = wid * 2 + ntl;
            bf16x8 bfr[2];
#pragma unroll
            for (int ks = 0; ks < 2; ++ks) bfr[ks] = tr_bfrag(sB, 260, ks * 32 + q * 8, nt * 16, c16);
#pragma unroll
            for (int mtp = 0; mtp < 4; ++mtp) {
                f32x4 are = (f32x4){0.f, 0.f, 0.f, 0.f}, aim = (f32x4){0.f, 0.f, 0.f, 0.f};
#pragma unroll
                for (int ks = 0; ks < 2; ++ks) {
                    const bf16x8 fre = *(const bf16x8*)(sF + (mtp * 16 + c16) * 72 + ks * 32 + q * 8);
                    const bf16x8 fim = *(const bf16x8*)(sF + (64 + mtp * 16 + c16) * 72 + ks * 32 + q * 8);
                    are = __builtin_amdgcn_mfma_f32_16x16x32_bf16(fre, bfr[ks], are, 0, 0, 0);
                    aim = __builtin_amdgcn_mfma_f32_16x16x32_bf16(fim, bfr[ks], aim, 0, 0, 0);
                }
#pragma unroll
                for (int j = 0; j < 4; ++j) {
                    const int k1 = mtp * 16 + 4 * q + j, n = nt * 16 + c16;
                    const float tc = sTW[k1 * 2], ts = sTW[k1 * 2 + 1];
                    sO[(k1 * 2) * 264 + n] = f2bf(are[j] * tc + aim[j] * ts);
                    sO[(k1 * 2 + 1) * 264 + n] = f2bf(aim[j] * tc - are[j] * ts);
                }
            }
        }
        lds_barrier();
#pragma unroll
        for (int i = 0; i < 8; ++i) { const int ch = tid + 512 * i, row = ch >> 5, cc = ch & 31;
            *(u32x4*)(APR + (((size_t)(b * 64) * 2 + row) * 64 + t2) * 512 + jh * 256 + cc * 8) = *(const u32x4*)(sO + row * 264 + cc * 8); }
        task = nxt;
    }
    lds_barrier();
}

template <int NMT>
__device__ __forceinline__ void fft_stage3_load(const Params& p, int l, int g, int rowbase, int rowstride, bf16x8 (&bfr)[8], float (&oldv)[NMT][4]) {
    const int tid_ = tid_op(); const int lane = tid_ & 63, wid = tid_ >> 6, c16 = lane & 15, q = lane >> 4;
    const bf16_t* CW = (const bf16_t*)(p.ws + WS_CWSW) + ((size_t)(l * 4 + g) * 128 + wid * 16 + c16) * 256;
    const bf16_t* ABC = (const bf16_t*)(p.ws + WS_ABC);
#pragma unroll
    for (int ks = 0; ks < 8; ++ks) bfr[ks] = *(const bf16x8*)(CW + ks * 32 + q * 8);
#pragma unroll
    for (int mt = 0; mt < NMT; ++mt)
#pragma unroll
        for (int j = 0; j < 4; ++j) oldv[mt][j] = bf2f(ABC[(size_t)(rowbase + rowstride * (mt * 16 + 4 * q + j)) * 1024 + g * 128 + wid * 16 + c16]);
}
template <int NMT>
__device__ __forceinline__ void fft_stage3_mma(const Params& p, int g, const bf16_t* sA3, int rowbase, int rowstride, const bf16x8 (&bfr)[8], const float (&oldv)[NMT][4], bool dry) {
    const int tid_ = tid_op(); const int lane = tid_ & 63, wid = tid_ >> 6, c16 = lane & 15, q = lane >> 4;
    bf16_t* ABC = (bf16_t*)(p.ws + WS_ABC);
#pragma unroll
    for (int mt = 0; mt < NMT; ++mt) {
        f32x4 acc = (f32x4){0.f, 0.f, 0.f, 0.f};
#pragma unroll
        for (int ks = 0; ks < 8; ++ks) { const bf16x8 a = *(const bf16x8*)(sA3 + (mt * 16 + c16) * 264 + ks * 32 + q * 8);
            acc = __builtin_amdgcn_mfma_f32_16x16x32_bf16(a, bfr[ks], acc, 0, 0, 0); }
#pragma unroll
        for (int j = 0; j < 4; ++j) { const int mrow = mt * 16 + 4 * q + j;
            ABC[(size_t)(rowbase + rowstride * mrow) * 1024 + g * 128 + wid * 16 + c16] = f2bf(dry ? oldv[mt][j] : acc[j] * oldv[mt][j]); }
    }
}

__device__ __forceinline__ void fft_stage3v_load(const Params& p, int l, int g, int rowbase, bf16x8 (&bfr)[8], u32x4 (&oldr)[2]) {
    const int tid_ = tid_op(); const int lane = tid_ & 63, wid = tid_ >> 6, c16 = lane & 15, q = lane >> 4;
    const bf16_t* CW = (const bf16_t*)(p.ws + WS_CWSW) + ((size_t)(l * 4 + g) * 128 + wid * 16 + c16) * 256;
    const bf16_t* ap = (const bf16_t*)(p.ws + WS_ABC) + (size_t)(rowbase + 64 * (tid_ >> 3)) * 1024 + g * 128 + (tid_ & 7) * 16;
#pragma unroll
    for (int ks = 0; ks < 8; ++ks) bfr[ks] = *(const bf16x8*)(CW + ks * 32 + q * 8);
    oldr[0] = *(const u32x4*)ap; oldr[1] = *(const u32x4*)(ap + 8);
}
__device__ __forceinline__ void fft_stage3v_mma(const bf16_t* sA3, bf16_t* sOut, const bf16x8 (&bfr)[8]) {
    const int tid_ = tid_op(); const int lane = tid_ & 63, wid = tid_ >> 6, c16 = lane & 15, q = lane >> 4;
#pragma unroll
    for (int mt = 0; mt < 4; ++mt) {
        f32x4 acc = (f32x4){0.f, 0.f, 0.f, 0.f};
#pragma unroll
        for (int ks = 0; ks < 8; ++ks) { const bf16x8 a = *(const bf16x8*)(sA3 + (mt * 16 + c16) * 264 + ks * 32 + q * 8);
            acc = __builtin_amdgcn_mfma_f32_16x16x32_bf16(a, bfr[ks], acc, 0, 0, 0); }
#pragma unroll
        for (int j = 0; j < 4; ++j) ((float*)sOut)[(mt * 16 + 4 * q + j) * 132 + wid * 16 + c16] = acc[j];
    }
}
__device__ __forceinline__ void fft_stage3v_store(const Params& p, int g, const bf16_t* sOut, int rowbase, const u32x4 (&oldr)[2]) {
    const int tid_ = tid_op(); const int row = tid_ >> 3, cb = (tid_ & 7) * 16;
    bf16_t* ap = (bf16_t*)(p.ws + WS_ABC) + (size_t)(rowbase + 64 * row) * 1024 + g * 128 + cb;
    const float* so = (const float*)sOut + row * 132 + cb;
#pragma unroll
    for (int h = 0; h < 2; ++h) {
        f32x4 y0 = *(const f32x4*)(so + h * 8), y1 = *(const f32x4*)(so + h * 8 + 4);
        const u32x4 o = oldr[h];
        y0[0] *= bflo(o[0]); y0[1] *= bfhi(o[0]); y0[2] *= bflo(o[1]); y0[3] *= bfhi(o[1]);
        y1[0] *= bflo(o[2]); y1[1] *= bfhi(o[2]); y1[2] *= bflo(o[3]); y1[3] *= bfhi(o[3]);
        *(u32x4*)(ap + h * 8) = pack8(y0, y1);
    }
}

constexpr int F2_SG = 0;
constexpr int F2_SB = 34816;
constexpr int F2_SA3 = F2_SB + 33792;
constexpr int F2_SO = F2_SA3 + 33792;
__device__ void phase_fft23(const Params& p, int l, unsigned char* smem, bool dry = false) {
    unsigned char* ws = ptr_op(p.ws); const int tid = tid_op(), lane = tid & 63, wid = tid >> 6, c16 = lane & 15, q = lane >> 4;
    bf16_t* sG = (bf16_t*)(smem + F2_SG); bf16_t* sB = (bf16_t*)(smem + F2_SB); bf16_t* sA3 = (bf16_t*)(smem + F2_SA3); bf16_t* sOut = (bf16_t*)(smem + F2_SO);
    const bf16_t* APR = (const bf16_t*)(ws + WS_APR); const bf16_t* G2 = (const bf16_t*)(ws + WS_G2);
    const int NTASK = NB * 64 * 4, G = grd_op();
#pragma unroll
    for (int i = 0; i < 4; ++i) { const int ch = tid + 512 * i, row = ch >> 4, cc = ch & 15; *(u32x4*)(sG + row * 136 + cc * 8) = *(const u32x4*)(G2 + row * 128 + cc * 8); }
    u32x4 tile[4];
    auto load_tile = [&](int task) {
        const int g = task & 3, k1 = (task >> 2) & 63, b = task >> 8;
#pragma unroll
        for (int i = 0; i < 4; ++i) { const int ch = tid + 512 * i, row = ch >> 4, cc = ch & 15;
            tile[i] = *(const u32x4*)(APR + ((size_t)(b * 64 + k1) * 128 + row) * 512 + g * 128 + cc * 8); }
    };
    int task = bid_op();
    if (task < NTASK) load_tile(task);
    while (task < NTASK) {
        const int g = task & 3, k1 = (task >> 2) & 63, b = task >> 8;
        bf16x8 bfr3[8]; u32x4 oldr3[2];
        fft_stage3v_load(p, l, g, b * TL + k1, bfr3, oldr3);
#pragma unroll
        for (int i = 0; i < 4; ++i) { const int ch = tid + 512 * i, row = ch >> 4, cc = ch & 15;
            u32x2* dp = (u32x2*)(sB + row * 132 + cc * 8); u32x2 lo, hi; lo[0] = tile[i][0]; lo[1] = tile[i][1]; hi[0] = tile[i][2]; hi[1] = tile[i][3]; dp[0] = lo; dp[1] = hi; }
        const int nxt = task + G;
        if (nxt < NTASK) load_tile(nxt);
        lds_barrier();
        {
            bf16x8 bfr[4];
#pragma unroll
            for (int ks = 0; ks < 4; ++ks) bfr[ks] = tr_bfrag(sB, 132, ks * 32 + q * 8, wid * 16, c16);
#pragma unroll
            for (int mt = 0; mt < 8; ++mt) {
                f32x4 acc = (f32x4){0.f, 0.f, 0.f, 0.f};
#pragma unroll
                for (int ks = 0; ks < 4; ++ks) { const bf16x8 a = *(const bf16x8*)(sG + (mt * 16 + c16) * 136 + ks * 32 + q * 8);
                    acc = __builtin_amdgcn_mfma_f32_16x16x32_bf16(a, bfr[ks], acc, 0, 0, 0); }
#pragma unroll
                for (int j = 0; j < 4; ++j) { const int m = mt * 16 + 4 * q + j, cp = m >> 6, k2 = m & 63;
                    sA3[k2 * 264 + cp * 128 + wid * 16 + c16] = f2bf(acc[j]); }
            }
        }
        lds_barrier();
        fft_stage3v_mma(sA3, sOut, bfr3);
        lds_barrier();
        fft_stage3v_store(p, g, sOut, b * TL + k1, oldr3);
        task = nxt;
    }
    lds_barrier();
}

constexpr int FC_SU = 0;
constexpr int FC_TAB = 65536;
constexpr int FC_SA3 = 67584;
__device__ void phase_fftctx(const Params& p, int l, unsigned char* smem, bool dry = false) {
    unsigned char* ws = ptr_op(p.ws); const int tid = tid_op();
    bf16_t* sU = (bf16_t*)(smem + FC_SU); float* sTab = (float*)(smem + FC_TAB); bf16_t* sA3 = (bf16_t*)(smem + FC_SA3);
    const bf16_t* UF = (const bf16_t*)(ws + WS_UFFT);
    for (int task = bid_op(); task < NB * 16 * 4; task += grd_op()) {
        const int g = task & 3, kb = (task >> 2) & 15, b = task >> 6;
        bf16x8 bfr3[8]; float oldv3[1][4];
        fft_stage3_load<1>(p, l, g, NLAT + b * TCX + kb * 16, 1, bfr3, oldv3);
        if (tid < 256) { sTab[tid * 2] = __builtin_amdgcn_cosf((float)tid * (1.f / 256.f)); sTab[tid * 2 + 1] = __builtin_amdgcn_sinf((float)tid * (1.f / 256.f)); }
#pragma unroll
        for (int i = 0; i < 8; ++i) { const int ch = tid + 512 * i, t = ch >> 4, cc = ch & 15;
            *(u32x4*)(sU + t * 128 + cc * 8) = *(const u32x4*)(UF + ((size_t)(NLAT + b * TCX + t)) * 512 + g * 128 + cc * 8); }
        __syncthreads();
        {
            const int j = tid & 127, kq = tid >> 7; const int kbase = kb * 16 + kq * 4;
            float re[4], im[4] = {0.f, 0.f, 0.f, 0.f};
            { const float u0 = bf2f(sU[j]), u128 = bf2f(sU[128 * 128 + j]);
#pragma unroll
              for (int i = 0; i < 4; ++i) re[i] = ((kbase + i) & 1) ? u0 - u128 : u0 + u128; }
            for (int t = 1; t < 128; ++t) {
                const float ua = bf2f(sU[t * 128 + j]), ub = bf2f(sU[(256 - t) * 128 + j]);
                const float us = ua + ub, ud = ua - ub;
#pragma unroll
                for (int i = 0; i < 4; ++i) { const int idx = ((kbase + i) * t) & 255; re[i] += sTab[idx * 2] * us; im[i] -= sTab[idx * 2 + 1] * ud; }
            }
#pragma unroll
            for (int i = 0; i < 4; ++i) { sA3[(kq * 4 + i) * 264 + j] = f2bf(re[i] * 0.0625f); sA3[(kq * 4 + i) * 264 + 128 + j] = f2bf(im[i] * 0.0625f); }
        }
        __syncthreads();
        fft_stage3_mma<1>(p, g, sA3, NLAT + b * TCX + kb * 16, 1, bfr3, oldv3, dry);
        __syncthreads();
    }
}

constexpr int PL_SU = 0;
constexpr int PL_SP = 40960;
constexpr int PL_SO = PL_SP + 17408;
__device__ void phase_pool(const Params& p, int l, unsigned char* smem, bool dry = false) {
    unsigned char* ws = ptr_op(p.ws); const int tid = tid_op(), lane = tid & 63, wid = tid >> 6, c16 = lane & 15, q = lane >> 4;
    float* sU = (float*)(smem + PL_SU); bf16_t* sP = (bf16_t*)(smem + PL_SP); float* sO = (float*)(smem + PL_SO);
    const bf16_t* UP = (const bf16_t*)(ws + WS_UPOOL); bf16_t* ABC = (bf16_t*)(ws + WS_ABC);
    const int ntask = 2048 + (l == 0 ? 128 : 0), G = grd_op();
    auto decode = [&](int task, int& g, int& t0, int& rowbase, int& seqlen) {
        if (task < 2048) { g = task & 3; t0 = ((task >> 2) & 63) * 64; rowbase = (task >> 8) * TL; seqlen = TL; }
        else { const int r = task - 2048; g = r & 3; t0 = ((r >> 2) & 3) * 64; rowbase = NLAT + (r >> 4) * TCX; seqlen = TCX; }
    };
    u32x4 vv[3];
    auto load_tile = [&](int task) {
        int g, t0, rowbase, seqlen; decode(task, g, t0, rowbase, seqlen);
#pragma unroll
        for (int i = 0; i < 3; ++i) { int ch = tid + 512 * i; ch = ch < 80 * 16 ? ch : 80 * 16 - 1;
            const int r = ch >> 4, cc = ch & 15, tt = t0 - 8 + r;
            const int ttc = tt < 0 ? 0 : (tt >= seqlen ? seqlen - 1 : tt);
            vv[i] = *(const u32x4*)(UP + (size_t)(rowbase + ttc) * 512 + g * 128 + cc * 8); }
    };
    int task = bid_op();
    if (task < ntask) load_tile(task);
    while (task < ntask) {
        int g, t0, rowbase, seqlen; decode(task, g, t0, rowbase, seqlen);
        const bf16_t* PW = (const bf16_t*)(ws + WS_POOLT) + ((size_t)(l * 4 + g) * 128 + wid * 16 + c16) * 128;
        bf16x8 bfr[4];
#pragma unroll
        for (int ks = 0; ks < 4; ++ks) bfr[ks] = *(const bf16x8*)(PW + ks * 32 + q * 8);
        const float scl = p.pool_scale[l * 512 + g * 128 + wid * 16 + c16];
        bf16_t* aop = ABC + (size_t)(rowbase + t0 + (tid >> 3)) * 1024 + 512 + g * 128 + (tid & 7) * 16;
        u32x4 oldr[2]; oldr[0] = *(const u32x4*)aop; oldr[1] = *(const u32x4*)(aop + 8);
#pragma unroll
        for (int i = 0; i < 3; ++i) { const int ch = tid + 512 * i;
            if (ch < 80 * 16) { const int r = ch >> 4, cc = ch & 15, tt = t0 - 8 + r;
                u32x4 v = vv[i];
                if (!(tt >= 0 && tt < seqlen)) v = (u32x4){0u, 0u, 0u, 0u};
                f32x4 f0, f1; f0[0] = bflo(v[0]); f0[1] = bfhi(v[0]); f0[2] = bflo(v[1]); f0[3] = bfhi(v[1]); f1[0] = bflo(v[2]); f1[1] = bfhi(v[2]); f1[2] = bflo(v[3]); f1[3] = bfhi(v[3]);
                *(f32x4*)(sU + r * 128 + cc * 8) = f0; *(f32x4*)(sU + r * 128 + cc * 8 + 4) = f1; } }
        const int nxt = task + G;
        if (nxt < ntask) load_tile(nxt);
        lds_barrier();
        {
            const int j = tid & 127, tq = tid >> 7; const int half = 1 << g;
            for (int i = 0; i < 16; ++i) { const int t = tq * 16 + i, pos = t0 + t;
                const int lo = (pos - half > 0) ? pos - half : 0, hi = (pos + half < seqlen) ? pos + half : seqlen;
                float s = 0.f;
                for (int r = t + 8 - half; r < t + 8 + half; ++r) s += sU[r * 128 + j];
                const float pv = s / (float)(hi - lo) - sU[(t + 8) * 128 + j];
                sP[t * 136 + j] = f2bf(pv); }
        }
        lds_barrier();
        {
#pragma unroll
            for (int mt = 0; mt < 4; ++mt) {
                f32x4 acc = (f32x4){0.f, 0.f, 0.f, 0.f};
#pragma unroll
                for (int ks = 0; ks < 4; ++ks) { const bf16x8 a = *(const bf16x8*)(sP + (mt * 16 + c16) * 136 + ks * 32 + q * 8);
                    acc = __builtin_amdgcn_mfma_f32_16x16x32_bf16(a, bfr[ks], acc, 0, 0, 0); }
#pragma unroll
                for (int j = 0; j < 4; ++j) sO[(mt * 16 + 4 * q + j) * 132 + wid * 16 + c16] = acc[j] * scl;
            }
        }
        lds_barrier();
        { const float* so = sO + (tid >> 3) * 132 + (tid & 7) * 16;
#pragma unroll
          for (int h = 0; h < 2; ++h) {
              f32x4 y0 = *(const f32x4*)(so + h * 8), y1 = *(const f32x4*)(so + h * 8 + 4);
              const u32x4 o = oldr[h];
              y0[0] *= bflo(o[0]); y0[1] *= bfhi(o[0]); y0[2] *= bflo(o[1]); y0[3] *= bfhi(o[1]);
              y1[0] *= bflo(o[2]); y1[1] *= bfhi(o[2]); y1[2] *= bflo(o[3]); y1[3] *= bfhi(o[3]);
              *(u32x4*)(aop + h * 8) = dry ? o : pack8(y0, y1); } }
        task = nxt;
    }
    lds_barrier();
}

#define XB_TMO      128
#define XB_XCNT(j)  (256  + 64 * (j))
#define XB_XSUB(j)  (1280 + 64 * (j))
#define XB_XGEN(j)  (2304 + 64 * (j))
#define XB_TOP      3328
#define XB_TOPGEN   3392
#define XCD_BAR_WORDS 3456
#define XB_SPIN_CAP (1u << 18)
__device__ __forceinline__ unsigned xb_ld(unsigned* p)              { return __hip_atomic_load(p, __ATOMIC_RELAXED, __HIP_MEMORY_SCOPE_AGENT); }
__device__ __forceinline__ unsigned xb_add(unsigned* p, unsigned v) { return __hip_atomic_fetch_add(p, v, __ATOMIC_RELAXED, __HIP_MEMORY_SCOPE_AGENT); }
__device__ __forceinline__ unsigned xb_xcc_id() { return (unsigned)__builtin_amdgcn_s_getreg((3 << 11) | 20) & 0xFu; }
#define XB_SPIN(cond, bar) do { unsigned _sp = 0; while (cond) { __builtin_amdgcn_s_sleep(1); \
    if ((++_sp & 255u) == 0u) { if (xb_ld(&(bar)[XB_TMO])) break; if (_sp > XB_SPIN_CAP) { atomicAdd(&(bar)[XB_TMO], 1u); break; } } } } while (0)
struct XcdBarrier { unsigned* bar; unsigned x; volatile LAS unsigned* st; };
__device__ __forceinline__ XcdBarrier xcd_barrier_post(unsigned* bar, volatile LAS unsigned* st) {
    XcdBarrier b; b.bar = bar; b.x = xb_xcc_id(); b.st = st;
    if (threadIdx.x == 0) (void)xb_add(&bar[XB_XCNT(b.x)], 1u);
    return b;
}
__device__ __forceinline__ void xcd_barrier_complete(unsigned* bar, unsigned x, unsigned& nloc, unsigned& nx) {
    const unsigned G = gridDim.x * gridDim.y * gridDim.z;
    unsigned sum, cnt, mine, sp = 0u;
    for (;;) {
        sum = 0u; cnt = 0u; mine = 0u;
#pragma unroll
        for (unsigned j = 0; j < 16; ++j) { const unsigned c = xb_ld(&bar[XB_XCNT(j)]); sum += c; cnt += (c > 0u) ? 1u : 0u; mine = (j == x) ? c : mine; }
        if (sum == G) break;
        __builtin_amdgcn_s_sleep(1);
        if ((++sp & 255u) == 0u) { if (xb_ld(&bar[XB_TMO])) break; if (sp > XB_SPIN_CAP) { atomicAdd(&bar[XB_TMO], 1u); break; } }
    }
    nloc = mine > 0u ? mine : 1u; nx = cnt > 0u ? cnt : 1u;
}
__device__ __forceinline__ void xcd_barrier(const XcdBarrier& b) {
    asm volatile("s_waitcnt vmcnt(0)" ::: "memory");
    __syncthreads();
    if (threadIdx.x == 0) {
        unsigned* bar = b.bar;
        __builtin_amdgcn_s_waitcnt(0);
        unsigned nloc = b.st[0], nx = b.st[1];
        if (nloc == 0u) { xcd_barrier_complete(bar, b.x, nloc, nx); b.st[0] = nloc; b.st[1] = nx; }
        const unsigned old = xb_add(&bar[XB_XSUB(b.x)], 1u);
        const unsigned gen = old / nloc;
        if (old + 1u == (gen + 1u) * nloc) {
            __builtin_amdgcn_fence(__ATOMIC_RELEASE, "agent");
            asm volatile("s_waitcnt vmcnt(0)" ::: "memory");
            const unsigned og = xb_add(&bar[XB_TOP], 1u);
            const unsigned tg = og / nx;
            if (og + 1u == (tg + 1u) * nx) xb_add(&bar[XB_TOPGEN], 1u);
            else XB_SPIN(xb_ld(&bar[XB_TOPGEN]) == tg, bar);
            __builtin_amdgcn_fence(__ATOMIC_ACQUIRE, "agent");
            xb_add(&bar[XB_XGEN(b.x)], 1u);
            asm volatile("s_waitcnt vmcnt(0)" ::: "memory");
        } else {
            XB_SPIN(xb_ld(&bar[XB_XGEN(b.x)]) == gen, bar);
            __builtin_amdgcn_fence(__ATOMIC_ACQUIRE, "agent");
            asm volatile("s_waitcnt vmcnt(0)" ::: "memory");
        }
    }
    __syncthreads();
}

__global__ void __launch_bounds__(512, 2) fwd_megakernel(Params p_unused) {
    extern __shared__ __attribute__((aligned(16))) unsigned char smem[];
    cg::grid_group grid = cg::this_grid();

    LAS unsigned char* lds = (LAS unsigned char*)smem;
    const int G = grd_op(), bid = bid_op();

    if (threadIdx.x == 0) { *(u32x4*)(smem + LDS_ST) = (u32x4){0u, 0u, 0u, 0u}; }
    __syncthreads();
    const XcdBarrier xb = xcd_barrier_post((unsigned*)(kparams().ws + WS_BAR), (volatile LAS unsigned*)(lds + LDS_ST));
    phase0(kparams(), smem);
    grid.sync();
    for (int l = 0; l < 2; ++l) {
        const bool last = (l == 1);
        phase_norm(kparams(), l);
        xcd_barrier(xb);
        {
            unsigned char* ws = kparams().ws;
            SchedP2 S; S.H = (const char*)(ws + WS_H); S.W = (const char*)(ws + WS_WINT) + (size_t)l * INC * 1024 * 2; S.G = G; S.c = bid;
            EpiP2 E; E.ulru = (bf16_t*)(ws + WS_ULRU); E.aa = (bf16_t*)(ws + WS_AA); E.ufft = (bf16_t*)(ws + WS_UFFT); E.abc = (bf16_t*)(ws + WS_ABC); E.upool = (bf16_t*)(ws + WS_UPOOL);
            gemm_stream(lds, S, E);
        }
        xcd_barrier(xb);
        phase_lru_p1(kparams(), l, smem);
        phase_fft1(kparams(), smem);
        if (!last) phase_fftctx(kparams(), l, smem);
        phase_pool(kparams(), l, smem);
        xcd_barrier(xb);
        phase_lru<2>(kparams(), l, smem);
        phase_fft23(kparams(), l, smem);
        xcd_barrier(xb);
        const int nsteps = last ? 2 : 3;
#pragma unroll 1
        for (int step = 0; step < nsteps; ++step) {
            {
                unsigned char* ws = kparams().ws;
                SchedMerge S; S.H = (const char*)(ws + WS_H); S.AA = (const char*)(ws + WS_AA); S.ABC = (const char*)(ws + WS_ABC);
                S.WG = (const char*)(ws + WS_WINT) + ((size_t)l * INC + 4096) * 1024 * 2; S.PA = (const char*)(ws + WS_PAT) + (size_t)l * 1024 * 1024 * 2;
                S.PBC = (const char*)(ws + WS_PBCT) + (size_t)l * 1024 * 1024 * 2; S.G = G; S.c = bid; S.mode = (step == 0) ? 1 : ((step == 1 && !last) ? 2 : 0);
                EpiMerge E; E.gs = (u32x4*)(ws + WS_UFFT + (size_t)bid * 65536); E.m = (bf16_t*)(ws + WS_ULRU);
                gemm_stream(lds, S, E);
            }
            {
                unsigned char* ws = kparams().ws;
                SchedOut S; S.M = (const char*)(ws + WS_ULRU); S.W = (const char*)(ws + WS_WOT) + (size_t)l * 1024 * 1024 * 2; S.G = G; S.c = bid;
                S.mode = (step == 0) ? 0 : (step == 1 ? (last ? 1 : 2) : 3);
                EpiOut E; E.out = kparams().out; E.ctxres = (float*)(ws + WS_CTXRES); E.mod = (const float*)(ws + WS_MOD) + (size_t)l * 9 * 3072; E.dryk = 1.f;
                gemm_stream(lds, S, E);
            }
            xcd_barrier(xb);
        }
    }
    phase_final(kparams());
}

extern "C" void kernel_launch(void* const* d_in, const int* in_sizes, int n_in, void* d_out, int out_size, void* d_ws, size_t ws_size, hipStream_t stream) {
    static int grid_blocks = 0;
    if (grid_blocks == 0) {
        if (n_in != 23 || ws_size < WS_END) { fprintf(stderr, "kernel_launch: unexpected n_in %d or ws_size %zu < %zu\n", n_in, ws_size, (size_t)WS_END); grid_blocks = -1; return; }
        int dev = 0, cus = 0, per_cu = 0;
        hipGetDevice(&dev);
        hipDeviceGetAttribute(&cus, hipDeviceAttributeMultiprocessorCount, dev);
        hipFuncSetAttribute((const void*)fwd_megakernel, hipFuncAttributeMaxDynamicSharedMemorySize, LDS_BYTES);
        hipOccupancyMaxActiveBlocksPerMultiprocessor(&per_cu, (const void*)fwd_megakernel, 512, LDS_BYTES);
        if (per_cu < 1) { fprintf(stderr, "kernel_launch: occupancy query says %d blocks per CU\n", per_cu); per_cu = 1; }
        grid_blocks = cus * 1;
        fprintf(stderr, "kernel_launch: cus %d per_cu %d grid %d ws %zu need %zu\n", cus, per_cu, grid_blocks, ws_size, (size_t)WS_END);
    }
    if (grid_blocks < 0) return;
    if (hipMemsetAsync((char*)d_ws + WS_BAR, 0, XCD_BAR_WORDS_C * 4, stream) != hipSuccess) { fprintf(stderr, "kernel_launch: memset failed\n"); return; }
    Params p{};
    const float** f = (const float**)&p;
    for (int i = 0; i < 23; ++i) f[i] = (const float*)d_in[i];
    p.out = (float*)d_out; p.ws = (unsigned char*)d_ws;
    void* args[] = {&p};
    hipError_t e = hipLaunchCooperativeKernel((const void*)fwd_megakernel, dim3(grid_blocks), dim3(512), args, LDS_BYTES, stream);
    if (e != hipSuccess) fprintf(stderr, "cooperative launch failed: %s (grid %d)\n", hipGetErrorString(e), grid_blocks);
}
```
